# Optimizing an MI355X kernel written in HIP

```python
import jax, jax.numpy as jnp
from jax import lax
import numpy as np

D_MODEL = 2048
BATCH = 4
SEQ = 2048
DEPTH = 4
DEC_BATCH = 128
DEC_SEQ = 4
PAST_LEN = 16384
PAGE_SIZE = 128

D_A = D_MODEL // 2
D_B = D_MODEL
CONV_A_W = 3
CONV_B_W = 4
N_BLOCKS = 16
BLOCK = D_B // N_BLOCKS
C_LRU = 8.0
FFN_HIDDEN = -(-8 * D_MODEL // (3 * 256)) * 256
EPS = 1e-6
IN_COLS = 3 * D_A + 2 * D_B + 2 * D_MODEL
SPLITS = [D_A, 2 * D_A, 3 * D_A, 3 * D_A + D_B, 3 * D_A + 2 * D_B, 3 * D_A + 2 * D_B + D_MODEL]

kernel_name = "hybrid_conv_rglru_decoder_step"


def rms_norm(x, g):
    xf = x.astype(jnp.float32)
    var = jnp.mean(xf * xf, axis=-1, keepdims=True)
    return (xf * lax.rsqrt(var + EPS) * g.astype(jnp.float32)).astype(x.dtype)


def causal_dwconv(u, buf, w):
    width = w.shape[0]
    t = u.shape[1]
    full = jnp.concatenate([buf.astype(u.dtype), u], axis=1)
    y = full[:, 0:t] * w[0]
    for k in range(1, width):
        y = y + full[:, k:k + t] * w[k]
    return y, full[:, full.shape[1] - (width - 1):]


def block_diag(x, w, b):
    xb = x.reshape(x.shape[0], x.shape[1], N_BLOCKS, BLOCK)
    y = jnp.einsum('bthi,hij->bthj', xb, w)
    return y.reshape(x.shape) + b


def rg_lru(x, h0, w_r, b_r, w_i, b_i, lam):
    r = jax.nn.sigmoid(block_diag(x, w_r, b_r).astype(jnp.float32))
    i = jax.nn.sigmoid(block_diag(x, w_i, b_i).astype(jnp.float32))
    log_a = C_LRU * r * jax.nn.log_sigmoid(lam.astype(jnp.float32))
    a = jnp.exp(log_a)
    mult = jnp.sqrt(-jnp.expm1(2.0 * log_a))
    b = mult * i * x.astype(jnp.float32)
    b = b.at[:, 0].add(a[:, 0] * h0.astype(jnp.float32))

    def combine(left, right):
        a1, b1 = left
        a2, b2 = right
        return a1 * a2, a2 * b1 + b2

    _, h = lax.associative_scan(combine, (a, b), axis=1)
    return h.astype(x.dtype), h[:, -1].astype(h0.dtype)


def hybrid_layer(x, buf_a, buf_b, h0, w_in, conv_a_w, w_out_a, conv_b_w, conv_b_bias,
                 w_r, b_r, w_i, b_i, lam, w_out_b, w_o, g_pre_mix, g_post_mix,
                 g_pre_ffn, g_post_ffn, w_gate_up, w_down):
    u = rms_norm(x, g_pre_mix)
    proj = jnp.einsum('btd,dp->btp', u, w_in)
    a_bg, a_cg, a_x, b_x, b_gate, gate_a, gate_b = jnp.split(proj, SPLITS, axis=-1)
    conv_out, new_a = causal_dwconv(a_cg * a_x, buf_a, conv_a_w)
    y_a = jnp.einsum('btc,cd->btd', a_bg * conv_out, w_out_a)
    xb, new_b = causal_dwconv(b_x, buf_b, conv_b_w)
    xb = xb + conv_b_bias
    h_seq, h_last = rg_lru(xb, h0, w_r, b_r, w_i, b_i, lam)
    y_b = jnp.einsum('btc,cd->btd', h_seq * jax.nn.gelu(b_gate), w_out_b)
    merged = jax.nn.sigmoid(gate_a) * y_a + jax.nn.sigmoid(gate_b) * y_b
    mix = jnp.einsum('btd,de->bte', merged, w_o)
    x = x + rms_norm(mix, g_post_mix)
    v = rms_norm(x, g_pre_ffn)
    gu = jnp.einsum('btd,df->btf', v, w_gate_up)
    g, up = jnp.split(gu, 2, axis=-1)
    f = jnp.einsum('btf,fd->btd', jax.nn.silu(g) * up, w_down)
    x = x + rms_norm(f, g_post_ffn)
    return x, new_a, new_b, h_last


def setup_inputs(seed: int = 0) -> dict:
    key = jax.random.key(seed)
    ks = jax.random.split(key, 24)
    nrm = lambda k, shape, s: jax.random.normal(k, shape, jnp.float32) * s
    u = jax.random.uniform(ks[10], (DEPTH, D_B), jnp.float32, 0.9, 0.999)
    p = u ** (1.0 / C_LRU)
    lam = jnp.log(p) - jnp.log1p(-p)
    return {
        "x_prompt": nrm(ks[0], (BATCH, SEQ, D_MODEL), 1.0),
        "x_sample": nrm(ks[1], (DEC_BATCH, DEC_SEQ, D_MODEL), 1.0),
        "state_conv_a": nrm(ks[2], (DEPTH, DEC_BATCH, CONV_A_W - 1, D_A), 1.0),
        "state_conv_b": nrm(ks[3], (DEPTH, DEC_BATCH, CONV_B_W - 1, D_B), 1.0),
        "state_lru_h": nrm(ks[4], (DEPTH, DEC_BATCH, D_B), 0.5),
        "w_in": nrm(ks[5], (DEPTH, D_MODEL, IN_COLS), D_MODEL ** -0.5),
        "conv_a_w": nrm(ks[6], (DEPTH, CONV_A_W, D_A), CONV_A_W ** -0.5),
        "w_out_a": nrm(ks[7], (DEPTH, D_A, D_MODEL), D_A ** -0.5),
        "conv_b_w": nrm(ks[8], (DEPTH, CONV_B_W, D_B), CONV_B_W ** -0.5),
        "conv_b_bias": nrm(ks[9], (DEPTH, D_B), 0.02),
        "w_r": nrm(ks[11], (DEPTH, N_BLOCKS, BLOCK, BLOCK), BLOCK ** -0.5),
        "b_r": nrm(ks[12], (DEPTH, D_B), 0.02),
        "w_i": nrm(ks[13], (DEPTH, N_BLOCKS, BLOCK, BLOCK), BLOCK ** -0.5),
        "b_i": nrm(ks[14], (DEPTH, D_B), 0.02),
        "lru_lambda": lam,
        "w_out_b": nrm(ks[15], (DEPTH, D_B, D_MODEL), D_B ** -0.5),
        "w_o": nrm(ks[16], (DEPTH, D_MODEL, D_MODEL), D_MODEL ** -0.5),
        "norm_pre_mix": 1.0 + nrm(ks[17], (DEPTH, D_MODEL), 0.02),
        "norm_post_mix": 1.0 + nrm(ks[18], (DEPTH, D_MODEL), 0.02),
        "norm_pre_ffn": 1.0 + nrm(ks[19], (DEPTH, D_MODEL), 0.02),
        "norm_post_ffn": 1.0 + nrm(ks[20], (DEPTH, D_MODEL), 0.02),
        "w_gate_up": nrm(ks[21], (DEPTH, D_MODEL, 2 * FFN_HIDDEN), D_MODEL ** -0.5),
        "w_down": nrm(ks[22], (DEPTH, FFN_HIDDEN, D_MODEL), FFN_HIDDEN ** -0.5),
    }


def reference(x_prompt, x_sample, state_conv_a, state_conv_b, state_lru_h, w_in, conv_a_w,
              w_out_a, conv_b_w, conv_b_bias, w_r, b_r, w_i, b_i, lru_lambda, w_out_b, w_o,
              norm_pre_mix, norm_post_mix, norm_pre_ffn, norm_post_ffn, w_gate_up, w_down):
    bp = x_prompt.shape[0]
    dt = x_prompt.dtype
    zero_a = jnp.zeros((bp, CONV_A_W - 1, D_A), dt)
    zero_b = jnp.zeros((bp, CONV_B_W - 1, D_B), dt)
    zero_h = jnp.zeros((bp, D_B), state_lru_h.dtype)
    xp, xs = x_prompt, x_sample
    pa, pb, ph, sa, sb, sh = [], [], [], [], [], []
    for l in range(DEPTH):
        w = (w_in[l], conv_a_w[l], w_out_a[l], conv_b_w[l], conv_b_bias[l], w_r[l], b_r[l],
             w_i[l], b_i[l], lru_lambda[l], w_out_b[l], w_o[l], norm_pre_mix[l],
             norm_post_mix[l], norm_pre_ffn[l], norm_post_ffn[l], w_gate_up[l], w_down[l])
        xp, na, nb, nh = hybrid_layer(xp, zero_a, zero_b, zero_h, *w)
        pa.append(na); pb.append(nb); ph.append(nh)
        xs, na, nb, nh = hybrid_layer(xs, state_conv_a[l], state_conv_b[l], state_lru_h[l], *w)
        sa.append(na); sb.append(nb); sh.append(nh)
    return (xp, xs, jnp.stack(pa), jnp.stack(pb), jnp.stack(ph),
            jnp.stack(sa), jnp.stack(sb), jnp.stack(sh))
```

```cpp
#include <hip/hip_runtime.h>
#include <cstdio>
#include <cstdint>

#ifndef MK_PER_PHASE
#define MK_PER_PHASE 0
#endif

constexpr int DM = 2048, DA = 1024, DB = 2048, FF = 5632, NL = 4;
constexpr int MPR = 8192, MSA = 512, M = MPR + MSA;
constexpr int TSEQ = 2048, NB = 4, NS = 128;
constexpr int NIN = 11264;
constexpr int PP = 10240;
constexpr int C_CX = 0, C_ABG = 1024, C_BX = 2048, C_BG = 4096, C_GA = 6144, C_GB = 8192;
constexpr int ZP = 3072;
constexpr float EPS = 1e-6f;
constexpr int NCH = 32, CHL = 64;

constexpr size_t MiB = 1u << 20;
constexpr size_t WS_CTL = 0, CTL_ZERO_BYTES = 64 * 1024;
constexpr size_t WL_IN = 0, WL_AB = 44 * MiB, WL_O = 56 * MiB, WL_GU = 64 * MiB, WL_DN = 108 * MiB, WL_RI = 130 * MiB, WL_STRIDE = 131 * MiB;
constexpr size_t WS_W = 1 * MiB;
constexpr size_t WS_U = WS_W + NL * WL_STRIDE;
constexpr size_t WS_V = WS_U + 34 * MiB;
constexpr size_t WS_PROJ = WS_V + 34 * MiB;
constexpr size_t WS_Z = WS_PROJ + 170 * MiB;
constexpr size_t WS_TMP = WS_Z + 51 * MiB;
constexpr size_t WS_MRG = WS_TMP + 68 * MiB;
constexpr size_t WS_Y32 = WS_MRG + 34 * MiB;
constexpr size_t WS_HM = WS_Y32 + 68 * MiB;
constexpr size_t WS_SUM = WS_HM + 94 * MiB;
constexpr size_t WS_PARTS = WS_SUM + 2 * MiB;
constexpr size_t WS_RS = WS_PARTS + 64 * MiB;
constexpr size_t WS_END = WS_RS + 1 * MiB;
static_assert((size_t)M * PP * 2 <= 170 * MiB && (size_t)M * ZP * 2 <= 51 * MiB && (size_t)M * DM * 4 <= 68 * MiB && (size_t)M * FF * 2 <= 94 * MiB && (size_t)M * DM * 2 <= 34 * MiB, "ws map");
static_assert((size_t)NIN * DM * 2 <= 44 * MiB && (size_t)DM * ZP * 2 <= 12 * MiB && (size_t)DM * FF * 2 <= 22 * MiB, "weight map");

constexpr size_t O_X = 0;
constexpr size_t O_CAP = (size_t)M * DM;
constexpr size_t O_CBP = O_CAP + (size_t)NL * NB * 2 * DA;
constexpr size_t O_HP = O_CBP + (size_t)NL * NB * 3 * DB;
constexpr size_t O_CAS = O_HP + (size_t)NL * NB * DB;
constexpr size_t O_CBS = O_CAS + (size_t)NL * NS * 2 * DA;
constexpr size_t O_HS = O_CBS + (size_t)NL * NS * 3 * DB;
constexpr size_t O_END = O_HS + (size_t)NL * NS * DB;

namespace pg8 {
#define PG8_LAS __attribute__((address_space(3)))
typedef unsigned short bf16_t;
typedef short bf16x8 __attribute__((ext_vector_type(8)));
typedef float f32x4 __attribute__((ext_vector_type(4)));
typedef unsigned u32x4 __attribute__((ext_vector_type(4)));
constexpr int BM = 256, BK = 64, HALF = 128, HTB = HALF * BK * 2, STAGE_BYTES = 8 * HTB, NXCD = 8, WGM = 8;

__host__ __device__ __forceinline__ int lds_byte(int r, int c) { const int st = (r >> 4) * 2 + (c >> 5), rr = r & 15, cc = c & 31, ob = rr * 64 + cc * 2; return st * 1024 + (ob ^ (((ob >> 9) & 1) << 5)); }
__host__ __device__ __forceinline__ void stage_rc(int b, int& R, int& C) { const int st = b / 1024, sb = b % 1024, swz = sb ^ (((sb >> 9) & 1) << 5); R = (st >> 1) * 16 + swz / 64; C = (st & 1) * 32 + (swz % 64) / 2; }
__host__ __device__ __forceinline__ int perm32(int rho) { const int n = rho >> 4, i = rho & 15; return 8 * (i >> 2) + 4 * n + (i & 3); }

struct Unit { int pm, pn, k0, nt, kind, part; };
struct Gemm { const bf16_t* A; const bf16_t* Bt; int ld; };

__device__ __forceinline__ void tile_of(int wgid, int nM, int nN, int& pm, int& pn) {
    const int nwg = nM * nN;
    { const int q = nwg / NXCD, r = nwg % NXCD, xcd = wgid % NXCD, off = wgid / NXCD; wgid = (xcd < r ? xcd * (q + 1) : r * (q + 1) + (xcd - r) * q) + off; }
    const int nig = WGM * nN, gid = wgid / nig, fm = gid * WGM, gsz = (nM - fm) < WGM ? (nM - fm) : WGM;
    pm = fm + ((wgid % nig) % gsz); pn = (wgid % nig) / gsz;
}
struct OrderFull {
    int nM, nN, nwg, G, c, ntk;
    __device__ __forceinline__ void init(int M_, int N_, int K_, int G_, int c_) { nM = M_ / BM; nN = N_ / BM; nwg = nM * nN; G = G_; c = c_; ntk = K_ / BK; }
    __device__ __forceinline__ bool next(int i, Unit& u) const {
        const long L = (long)i * G + c; if (L >= nwg) return false;
        tile_of((int)L, nM, nN, u.pm, u.pn); u.k0 = 0; u.nt = ntk; u.kind = 0; u.part = 0; return true;
    }
    __device__ __forceinline__ void a_ready(const Unit&) const {}
    __device__ __forceinline__ void done(const Unit&) const {}
};
constexpr int NPT_M = 32, NPT_N = 8, NPT = NPT_M * NPT_N, NST = 16;
struct OrderTail {
    int G, c, ntk, nparts, n6;
    __device__ __forceinline__ void init(int K_, int nparts_, int n6_, int G_, int c_) { G = G_; c = c_; ntk = K_ / BK; nparts = nparts_; n6 = n6_; }
    __device__ __forceinline__ bool next(int i, Unit& u) const {
        const int np = c < NPT ? (NPT - c + G - 1) / G : 0;
        const bool isp = i < np;
        const int Lm = (i - np) * G + c;
        if (!isp && Lm >= NST * nparts) return false;
        int pm, pn; tile_of(isp ? i * G + c : 0, NPT_M, NPT_N, pm, pn);
        const int st = Lm % NST, p = Lm / NST;
        const int k6 = 6 * p * BK, k4 = (6 * n6 + 4 * (p - n6)) * BK;
        u.pm = isp ? pm : NPT_M + (st >> 3); u.pn = isp ? pn : (st & 7); u.kind = isp ? 0 : 1; u.part = isp ? 0 : p;
        u.k0 = isp ? 0 : (p < n6 ? k6 : k4); u.nt = isp ? ntk : (p < n6 ? 6 : 4);
        return true;
    }
    __device__ __forceinline__ void a_ready(const Unit&) const {}
    __device__ __forceinline__ void done(const Unit&) const {}
};
struct OrderG3 {
    int G, c;
    __device__ __forceinline__ void init(int G_, int c_) { G = G_; c = c_; }
    __device__ __forceinline__ bool next(int i, Unit& u) const {
        const int np = c < NPT ? (NPT - c + G - 1) / G : 0;
        const bool isp = i < 2 * np;
        const int Lm = (i - 2 * np) * G + c;
        if (!isp && Lm >= NST * 12) return false;
        int pm, pn; tile_of(isp ? (i >> 1) * G + c : 0, NPT_M, NPT_N, pm, pn);
        const int st = Lm % NST, p = Lm / NST, ps = i & 1;
        u.pm = isp ? pm : NPT_M + (st >> 3); u.pn = isp ? pn : (st & 7); u.kind = isp ? ps : 2; u.part = isp ? 0 : p;
        u.k0 = isp ? (ps ? DA : 0) : 4 * p * BK; u.nt = isp ? (ps ? DB / BK : DA / BK) : 4;
        return true;
    }
    __device__ __forceinline__ void a_ready(const Unit&) const {}
    __device__ __forceinline__ void done(const Unit&) const {}
};

__device__ __forceinline__ unsigned cvt_pk_bf16(float lo, float hi) { unsigned r; asm volatile("v_cvt_pk_bf16_f32 %0, %1, %2" : "=v"(r) : "v"(lo), "v"(hi)); return r; }
__device__ __forceinline__ float fsig(float x) { return __builtin_amdgcn_rcpf(1.0f + __builtin_amdgcn_exp2f(-1.4426950408889634f * x)); }
__device__ __forceinline__ float fgelu(float x) { return x * fsig(1.5957691216057308f * x * (1.0f + 0.044715f * x * x)); }
__device__ __forceinline__ float bflo(unsigned w) { return __uint_as_float(w << 16); }
__device__ __forceinline__ float bfhi(unsigned w) { return __uint_as_float(w & 0xffff0000u); }

struct EpiY {
    static constexpr bool PERM = true, AFTER_DRAIN = false, MUT = false, HAS_PRE = false;
    static __device__ __forceinline__ bool keep(const Unit&) { return false; }
    bf16_t* C; bf16_t* P;
    __device__ __forceinline__ void operator()(const f32x4 (&acc)[2][2][4][2], const Unit& u, int wr, int wc, int fr, int fq) const {
        const int col0 = u.pn * BM + wc * 32 + 8 * fq;
        if (u.kind == 0) {
            bf16_t* base = C + (size_t)(u.pm * BM + wr * 64 + fr) * DM + col0;
#pragma unroll
            for (int ai = 0; ai < 2; ++ai)
#pragma unroll
                for (int m = 0; m < 4; ++m) { bf16_t* rowp = base + (size_t)(ai * HALF + m * 16) * DM;
#pragma unroll
                    for (int bj = 0; bj < 2; ++bj) { const f32x4 v0 = acc[ai][bj][m][0], v1 = acc[ai][bj][m][1];
                        u32x4 w; w.x = cvt_pk_bf16(v0[0], v0[1]); w.y = cvt_pk_bf16(v0[2], v0[3]); w.z = cvt_pk_bf16(v1[0], v1[1]); w.w = cvt_pk_bf16(v1[2], v1[3]);
                        *(u32x4*)(rowp + bj * HALF) = w; } }
        } else {
            bf16_t* base = P + (size_t)u.part * MSA * DM + (size_t)((u.pm - NPT_M) * BM + wr * 64 + fr) * DM + col0;
#pragma unroll
            for (int ai = 0; ai < 2; ++ai)
#pragma unroll
                for (int m = 0; m < 4; ++m) { bf16_t* rowp = base + (size_t)(ai * HALF + m * 16) * DM;
#pragma unroll
                    for (int bj = 0; bj < 2; ++bj) { const f32x4 v0 = acc[ai][bj][m][0], v1 = acc[ai][bj][m][1];
                        u32x4 w; w.x = cvt_pk_bf16(v0[0], v0[1]); w.y = cvt_pk_bf16(v0[2], v0[3]); w.z = cvt_pk_bf16(v1[0], v1[1]); w.w = cvt_pk_bf16(v1[2], v1[3]);
                        *(u32x4*)(rowp + bj * HALF) = w; } }
        }
    }
};
struct EpiG1 {
    static constexpr bool PERM = true, AFTER_DRAIN = false, MUT = false, HAS_PRE = true;
    bf16_t* P; u32x4* GF; const float* RS;
    static __device__ __forceinline__ bool keep(const Unit&) { return false; }
    __device__ __forceinline__ void pre(const Unit& u, int wr, int fr, float (&rr)[2][4]) const {
#pragma unroll
        for (int ai = 0; ai < 2; ++ai)
#pragma unroll
            for (int m = 0; m < 4; ++m) rr[ai][m] = RS[u.pm * BM + wr * 64 + fr + ai * HALF + m * 16];
    }
    __device__ __forceinline__ void operator()(const f32x4 (&acc)[2][2][4][2], const Unit& u, int wr, int wc, int fr, int fq, const float (&rr)[2][4]) const {
        const int row0 = u.pm * BM + wr * 64 + fr, pn = u.pn;
        if (pn < 8) {
            const int col0 = C_CX + 128 * pn + wc * 32 + 8 * fq;
#pragma unroll
            for (int ai = 0; ai < 2; ++ai)
#pragma unroll
                for (int m = 0; m < 4; ++m) { bf16_t* rowp = P + (size_t)(row0 + ai * HALF + m * 16) * PP + col0; const float r2 = rr[ai][m] * rr[ai][m];
                    const f32x4 v0 = acc[ai][0][m][0] * acc[ai][1][m][0] * r2, v1 = acc[ai][0][m][1] * acc[ai][1][m][1] * r2;
                    u32x4 w; w.x = cvt_pk_bf16(v0[0], v0[1]); w.y = cvt_pk_bf16(v0[2], v0[3]); w.z = cvt_pk_bf16(v1[0], v1[1]); w.w = cvt_pk_bf16(v1[2], v1[3]);
                    *(u32x4*)rowp = w; }
        } else if (pn >= 28) {
            const int tidx = (wr * 4 + wc) * 64 + fq * 16 + fr;
#pragma unroll
            for (int ai = 0; ai < 2; ++ai)
#pragma unroll
                for (int m = 0; m < 4; ++m) {
                    f32x4 r0, r1, s0, s1; const float rs = -1.4426950408889634f * rr[ai][m];
#pragma unroll
                    for (int j = 0; j < 4; ++j) {
                        const float ea0 = 1.0f + __builtin_amdgcn_exp2f(rs * acc[ai][0][m][0][j]), eb0 = 1.0f + __builtin_amdgcn_exp2f(rs * acc[ai][1][m][0][j]);
                        const float ea1 = 1.0f + __builtin_amdgcn_exp2f(rs * acc[ai][0][m][1][j]), eb1 = 1.0f + __builtin_amdgcn_exp2f(rs * acc[ai][1][m][1][j]);
                        r0[j] = eb0 * __builtin_amdgcn_rcpf(ea0); s0[j] = __builtin_amdgcn_rcpf(eb0); r1[j] = eb1 * __builtin_amdgcn_rcpf(ea1); s1[j] = __builtin_amdgcn_rcpf(eb1); }
                    u32x4 w; w.x = cvt_pk_bf16(r0[0], r0[1]); w.y = cvt_pk_bf16(r0[2], r0[3]); w.z = cvt_pk_bf16(r1[0], r1[1]); w.w = cvt_pk_bf16(r1[2], r1[3]);
                    u32x4* gf = GF + ((size_t)((((u.pm * 16 + (pn - 28)) * 2 + ai) * 4 + m) * 2) * 512 + tidx);
                    gf[0] = w;
                    w.x = cvt_pk_bf16(s0[0], s0[1]); w.y = cvt_pk_bf16(s0[2], s0[3]); w.z = cvt_pk_bf16(s1[0], s1[1]); w.w = cvt_pk_bf16(s1[2], s1[3]);
                    gf[512] = w; }
        } else {
            const int act = pn < 20 ? 0 : 1;
            const int col0 = (pn < 12 ? C_ABG + 256 * (pn - 8) : C_BX + 256 * (pn - 12)) + wc * 32 + 8 * fq;
#pragma unroll
            for (int ai = 0; ai < 2; ++ai)
#pragma unroll
                for (int m = 0; m < 4; ++m) { bf16_t* rowp = P + (size_t)(row0 + ai * HALF + m * 16) * PP + col0;
#pragma unroll
                    for (int bj = 0; bj < 2; ++bj) { f32x4 v0 = acc[ai][bj][m][0] * rr[ai][m], v1 = acc[ai][bj][m][1] * rr[ai][m];
                        if (act == 1) {
#pragma unroll
                            for (int j = 0; j < 4; ++j) { v0[j] = fgelu(v0[j]); v1[j] = fgelu(v1[j]); } }
                        u32x4 w; w.x = cvt_pk_bf16(v0[0], v0[1]); w.y = cvt_pk_bf16(v0[2], v0[3]); w.z = cvt_pk_bf16(v1[0], v1[1]); w.w = cvt_pk_bf16(v1[2], v1[3]);
                        *(u32x4*)(rowp + bj * HALF) = w; } }
        }
    }
};
struct EpiG3 {
    static constexpr bool PERM = true, AFTER_DRAIN = false, MUT = true, HAS_PRE = false;
    const u32x4* GF; bf16_t* MRG; bf16_t* SL;
    static __device__ __forceinline__ bool keep(const Unit& u) { return u.kind == 0; }
    __device__ __forceinline__ void operator()(f32x4 (&acc)[2][2][4][2], const Unit& u, int wr, int wc, int fr, int fq) const {
        const int row0 = u.pm * BM + wr * 64 + fr, col0 = u.pn * BM + wc * 32 + 8 * fq;
        const bool needr = (u.kind == 0) || (u.kind == 2 && u.part < 4), needs = u.kind != 0;
        bf16_t* sbase = SL + (size_t)u.part * MSA * DM - (size_t)MPR * DM;
        const int tidx = (wr * 4 + wc) * 64 + fq * 16 + fr;
#pragma unroll
        for (int ai = 0; ai < 2; ++ai)
#pragma unroll
            for (int mh = 0; mh < 2; ++mh) {
                u32x4 gr[2][2], gs[2][2];
#pragma unroll
                for (int mm = 0; mm < 2; ++mm)
#pragma unroll
                    for (int bj = 0; bj < 2; ++bj) { const size_t row = (size_t)(row0 + ai * HALF + (2 * mh + mm) * 16);
                        gr[mm][bj] = (u32x4){0x3f803f80u, 0x3f803f80u, 0x3f803f80u, 0x3f803f80u}; gs[mm][bj] = gr[mm][bj];
                        const u32x4* gf = GF + ((size_t)((((u.pm * 16 + 2 * u.pn + bj) * 2 + ai) * 4 + (2 * mh + mm)) * 2) * 512 + tidx); (void)row;
                        if (needr) gr[mm][bj] = gf[0];
                        if (needs) gs[mm][bj] = gf[512]; }
#pragma unroll
                for (int mm = 0; mm < 2; ++mm)
#pragma unroll
                    for (int bj = 0; bj < 2; ++bj) { const int m = 2 * mh + mm; const size_t row = (size_t)(row0 + ai * HALF + m * 16);
                        const u32x4 a = gr[mm][bj], b = gs[mm][bj];
                        const f32x4 g0 = (f32x4){bflo(a.x), bfhi(a.x), bflo(a.y), bfhi(a.y)} * (f32x4){bflo(b.x), bfhi(b.x), bflo(b.y), bfhi(b.y)};
                        const f32x4 g1 = (f32x4){bflo(a.z), bfhi(a.z), bflo(a.w), bfhi(a.w)} * (f32x4){bflo(b.z), bfhi(b.z), bflo(b.w), bfhi(b.w)};
                        const f32x4 v0 = acc[ai][bj][m][0] * g0, v1 = acc[ai][bj][m][1] * g1;
                        if (u.kind == 0) { acc[ai][bj][m][0] = v0; acc[ai][bj][m][1] = v1; }
                        else if (u.kind == 1) { u32x4 w; w.x = cvt_pk_bf16(v0[0], v0[1]); w.y = cvt_pk_bf16(v0[2], v0[3]); w.z = cvt_pk_bf16(v1[0], v1[1]); w.w = cvt_pk_bf16(v1[2], v1[3]);
                            *(u32x4*)(MRG + row * DM + col0 + bj * HALF) = w; }
                        else { u32x4 w; w.x = cvt_pk_bf16(v0[0], v0[1]); w.y = cvt_pk_bf16(v0[2], v0[3]); w.z = cvt_pk_bf16(v1[0], v1[1]); w.w = cvt_pk_bf16(v1[2], v1[3]);
                            *(u32x4*)(sbase + row * DM + col0 + bj * HALF) = w; } }
            }
    }
};
struct EpiG5 {
    static constexpr bool PERM = true, AFTER_DRAIN = false, MUT = false, HAS_PRE = true;
    static __device__ __forceinline__ bool keep(const Unit&) { return false; }
    bf16_t* H; const float* RS;
    __device__ __forceinline__ void pre(const Unit& u, int wr, int fr, float (&rr)[2][4]) const {
#pragma unroll
        for (int ai = 0; ai < 2; ++ai)
#pragma unroll
            for (int m = 0; m < 4; ++m) rr[ai][m] = RS[u.pm * BM + wr * 64 + fr + ai * HALF + m * 16];
    }
    __device__ __forceinline__ void operator()(const f32x4 (&acc)[2][2][4][2], const Unit& u, int wr, int wc, int fr, int fq, const float (&rr)[2][4]) const {
        const int row0 = u.pm * BM + wr * 64 + fr, col0 = 128 * u.pn + wc * 32 + 8 * fq;
#pragma unroll
        for (int ai = 0; ai < 2; ++ai)
#pragma unroll
            for (int m = 0; m < 4; ++m) { bf16_t* rowp = H + (size_t)(row0 + ai * HALF + m * 16) * FF + col0;
                f32x4 v0, v1;
#pragma unroll
                for (int j = 0; j < 4; ++j) { const float r = rr[ai][m], a = acc[ai][0][m][0][j] * r, b = acc[ai][0][m][1][j] * r; v0[j] = a * fsig(a) * (acc[ai][1][m][0][j] * r); v1[j] = b * fsig(b) * (acc[ai][1][m][1][j] * r); }
                u32x4 w; w.x = cvt_pk_bf16(v0[0], v0[1]); w.y = cvt_pk_bf16(v0[2], v0[3]); w.z = cvt_pk_bf16(v1[0], v1[1]); w.w = cvt_pk_bf16(v1[2], v1[3]);
                *(u32x4*)rowp = w; }
    }
};

template <class Epi, class Sched, bool ALIGN_EPI = false, bool SP2 = false>
__device__ __forceinline__ void gemm_phase(PG8_LAS unsigned char* lds, const Gemm g, const Sched& S, const Epi& E) {
    int tid_ = threadIdx.x; asm volatile("" : "+v"(tid_));
    const int tid = tid_, wid = __builtin_amdgcn_readfirstlane(tid >> 6), lane = tid & 63, wr = wid >> 2, wc = wid & 3, fr = lane & 15, fq = lane >> 4;
    const int K = g.ld;
    unsigned voffA[2], voffB[2];
#pragma unroll
    for (int i = 0; i < 2; ++i) { int R, C; stage_rc(tid * 16 + i * 8192, R, C); const int Rb = Epi::PERM ? ((R & ~31) + perm32(R & 31)) : R;
        voffA[i] = (unsigned)(R * K + C) * 2u; voffB[i] = (unsigned)(Rb * K + C) * 2u; }
    const size_t kstep = (size_t)(BK * 2);
    const size_t hstep = (size_t)HALF * K * 2;
    const size_t tstep = 2 * hstep;
    const unsigned ldsw = (unsigned)wid * 1024u;
    const int aoff = lds_byte(wr * 64 + fr, fq * 8), boff = lds_byte(wc * 32 + fr, fq * 8);
#define PG8_SA(b, h) (((b) * 2 + (h)) * HTB)
#define PG8_SB(b, h) ((4 + (b) * 2 + (h)) * HTB)
#define PG8_STAGE(bufoff, gbase, voff) do { _Pragma("unroll") for (int _i = 0; _i < 2; ++_i) \
        __builtin_amdgcn_global_load_lds((const unsigned*)((const char*)(gbase) + (voff)[_i]), (PG8_LAS unsigned*)(lds + (bufoff) + ldsw + _i * 8192), 16, 0, 0); } while (0)
#define PG8_LDA(dst, b, h) do { _Pragma("unroll") for (int m = 0; m < 4; ++m) _Pragma("unroll") for (int k = 0; k < 2; ++k) dst[m][k] = *(const PG8_LAS bf16x8*)(lds + PG8_SA(b, h) + aoff + m * 2048 + k * 1024); } while (0)
#define PG8_LDB(dst, b, h) do { _Pragma("unroll") for (int n = 0; n < 2; ++n) _Pragma("unroll") for (int k = 0; k < 2; ++k) dst[n][k] = *(const PG8_LAS bf16x8*)(lds + PG8_SB(b, h) + boff + n * 2048 + k * 1024); } while (0)
#define PG8_MMA(ai, bj, At, Bt) do { __builtin_amdgcn_s_setprio(1); _Pragma("unroll") for (int m = 0; m < 4; ++m) _Pragma("unroll") for (int n = 0; n < 2; ++n) _Pragma("unroll") for (int k = 0; k < 2; ++k) \
        acc[ai][bj][m][n] = __builtin_amdgcn_mfma_f32_16x16x32_bf16(Bt[n][k], At[m][k], acc[ai][bj][m][n], 0, 0, 0); __builtin_amdgcn_s_setprio(0); } while (0)
#define PG8_WAIT_V(n) asm volatile("s_waitcnt vmcnt(" #n ")" ::: "memory")
#define PG8_WAIT_L(n) asm volatile("s_waitcnt lgkmcnt(" #n ")" ::: "memory")
#define PG8_BAR __builtin_amdgcn_s_barrier()
#define PG8_SCHED __builtin_amdgcn_sched_barrier(0)
    Unit cur, nxt; int ui = 0;
    if (!S.next(0, cur)) return;
    f32x4 acc[2][2][4][2];
#pragma unroll
    for (int a = 0; a < 2; ++a)
#pragma unroll
        for (int b = 0; b < 2; ++b)
#pragma unroll
            for (int m = 0; m < 4; ++m)
#pragma unroll
                for (int n = 0; n < 2; ++n) acc[a][b][m][n] = (f32x4){0.f, 0.f, 0.f, 0.f};
    bf16x8 At[4][2], B0[2][2], B1[2][2];
    const char* cA = (const char*)g.A + (size_t)cur.pm * tstep + (size_t)cur.k0 * 2; const char* cB = (const char*)g.Bt + (size_t)cur.pn * tstep + (size_t)cur.k0 * 2;
    S.a_ready(cur);
    float pre[2][4];
    if constexpr (Epi::HAS_PRE) E.pre(cur, wr, fr, pre);
    if constexpr (SP2) {
        PG8_STAGE(PG8_SB(0, 0), cB, voffB); PG8_STAGE(PG8_SB(0, 1), cB + hstep, voffB); PG8_STAGE(PG8_SA(0, 0), cA, voffA); PG8_STAGE(PG8_SA(0, 1), cA + hstep, voffA);
        if (wr == 1) PG8_BAR;
        PG8_WAIT_V(2); PG8_BAR;
        PG8_STAGE(PG8_SB(1, 0), cB + kstep, voffB); PG8_STAGE(PG8_SA(1, 0), cA + kstep, voffA); PG8_STAGE(PG8_SB(1, 1), cB + hstep + kstep, voffB);
        PG8_WAIT_V(6); PG8_BAR;
    } else {
        PG8_STAGE(PG8_SB(0, 0), cB, voffB); PG8_STAGE(PG8_SA(0, 0), cA, voffA); PG8_STAGE(PG8_SB(0, 1), cB + hstep, voffB); PG8_STAGE(PG8_SA(0, 1), cA + hstep, voffA);
        if (wr == 1) PG8_BAR;
        PG8_WAIT_V(4); PG8_BAR;
        PG8_STAGE(PG8_SB(1, 0), cB + kstep, voffB); PG8_STAGE(PG8_SA(1, 0), cA + kstep, voffA); PG8_STAGE(PG8_SB(1, 1), cB + hstep + kstep, voffB);
        PG8_WAIT_V(6); PG8_BAR;
    }
    for (;;) {
        const bool has_next = S.next(ui + 1, nxt);
        const char* nA = has_next ? (const char*)g.A + (size_t)nxt.pm * tstep + (size_t)nxt.k0 * 2 : cA; const char* nB = has_next ? (const char*)g.Bt + (size_t)nxt.pn * tstep + (size_t)nxt.k0 * 2 : cB;
        const int nt = cur.nt;
        for (int t = 0; t < nt; t += 2) {
            const bool last = (t == nt - 2);
            const char* a1 = cA + (size_t)(t + 1) * kstep;
            const char* a2 = last ? nA : cA + (size_t)(t + 2) * kstep; const char* b2 = last ? nB : cB + (size_t)(t + 2) * kstep;
            const char* a3 = a2 + kstep; const char* b3 = b2 + kstep;
            if (last && has_next) S.a_ready(nxt);
            if constexpr (SP2) {
            PG8_LDB(B0, 0, 0); PG8_LDB(B1, 0, 1); PG8_SCHED; PG8_LDA(At, 0, 0); PG8_STAGE(PG8_SA(1, 1), a1 + hstep, voffA);
            PG8_WAIT_V(8); PG8_WAIT_L(0); PG8_BAR; PG8_MMA(0, 0, At, B0); PG8_MMA(0, 1, At, B1); PG8_BAR; PG8_SCHED;
            PG8_LDA(At, 0, 1); PG8_STAGE(PG8_SB(0, 0), b2, voffB); PG8_STAGE(PG8_SB(0, 1), b2 + hstep, voffB); PG8_STAGE(PG8_SA(0, 0), a2, voffA);
            PG8_WAIT_V(8); PG8_WAIT_L(0); PG8_BAR; PG8_MMA(1, 0, At, B0); PG8_MMA(1, 1, At, B1); PG8_BAR; PG8_SCHED;
            PG8_LDB(B0, 1, 0); PG8_LDB(B1, 1, 1); PG8_SCHED; PG8_LDA(At, 1, 0); PG8_STAGE(PG8_SA(0, 1), a2 + hstep, voffA);
            PG8_WAIT_V(8); PG8_WAIT_L(0); PG8_BAR; PG8_MMA(0, 0, At, B0); PG8_MMA(0, 1, At, B1); PG8_BAR; PG8_SCHED;
            PG8_LDA(At, 1, 1); PG8_STAGE(PG8_SB(1, 0), b3, voffB); PG8_STAGE(PG8_SB(1, 1), b3 + hstep, voffB); PG8_STAGE(PG8_SA(1, 0), a3, voffA);
            PG8_WAIT_V(8); PG8_WAIT_L(0); PG8_BAR; PG8_MMA(1, 0, At, B0); PG8_MMA(1, 1, At, B1); PG8_BAR; PG8_SCHED;
            } else {
            PG8_LDB(B0, 0, 0); PG8_SCHED; PG8_LDA(At, 0, 0); PG8_STAGE(PG8_SA(1, 1), a1 + hstep, voffA);
            PG8_WAIT_L(8); PG8_BAR; PG8_WAIT_L(0); PG8_MMA(0, 0, At, B0); PG8_BAR; PG8_SCHED;
            PG8_LDB(B1, 0, 1); PG8_STAGE(PG8_SB(0, 0), b2, voffB);
            PG8_BAR; PG8_WAIT_L(0); PG8_MMA(0, 1, At, B1); PG8_BAR;
            PG8_LDA(At, 0, 1); PG8_STAGE(PG8_SA(0, 0), a2, voffA);
            PG8_BAR; PG8_WAIT_L(0); PG8_MMA(1, 0, At, B0); PG8_BAR; PG8_SCHED;
            PG8_STAGE(PG8_SB(0, 1), b2 + hstep, voffB);
            PG8_WAIT_V(6); PG8_BAR; PG8_MMA(1, 1, At, B1); PG8_BAR;
            PG8_LDB(B0, 1, 0); PG8_SCHED; PG8_LDA(At, 1, 0); PG8_STAGE(PG8_SA(0, 1), a2 + hstep, voffA);
            PG8_WAIT_L(8); PG8_BAR; PG8_WAIT_L(0); PG8_MMA(0, 0, At, B0); PG8_BAR; PG8_SCHED;
            PG8_LDB(B1, 1, 1); PG8_STAGE(PG8_SB(1, 0), b3, voffB);
            PG8_BAR; PG8_WAIT_L(0); PG8_MMA(0, 1, At, B1); PG8_BAR;
            PG8_LDA(At, 1, 1); PG8_STAGE(PG8_SA(1, 0), a3, voffA);
            PG8_BAR; PG8_WAIT_L(0); PG8_MMA(1, 0, At, B0); PG8_BAR; PG8_SCHED;
            PG8_STAGE(PG8_SB(1, 1), b3 + hstep, voffB);
            PG8_WAIT_V(6); PG8_BAR; PG8_MMA(1, 1, At, B1); PG8_BAR;
            }
        }
        if constexpr (ALIGN_EPI) { if (wr == 0) PG8_BAR; }
        if constexpr (Epi::HAS_PRE) { E(acc, cur, wr, wc, fr, fq, pre); } else { E(acc, cur, wr, wc, fr, fq); }
        if (!has_next) break;
        if (!Epi::keep(cur)) {
#pragma unroll
        for (int a = 0; a < 2; ++a)
#pragma unroll
            for (int b = 0; b < 2; ++b)
#pragma unroll
                for (int m = 0; m < 4; ++m)
#pragma unroll
                    for (int n = 0; n < 2; ++n) acc[a][b][m][n] = (f32x4){0.f, 0.f, 0.f, 0.f};
        }
        cur = nxt; cA = nA; cB = nB; ++ui;
        if constexpr (Epi::HAS_PRE) E.pre(cur, wr, fr, pre);
        if constexpr (ALIGN_EPI) { if (wr == 1) PG8_BAR; }
    }
    PG8_WAIT_V(0);
    if constexpr (!ALIGN_EPI) { if (wr == 0) PG8_BAR; }
    PG8_BAR;
#undef PG8_SA
#undef PG8_SB
#undef PG8_STAGE
#undef PG8_LDA
#undef PG8_LDB
#undef PG8_MMA
#undef PG8_WAIT_V
#undef PG8_WAIT_L
#undef PG8_BAR
#undef PG8_SCHED
}
}

constexpr int NWAVES = 8;
constexpr int RING_OFF = 0, RING_BYTES = 131072;
constexpr int LDSCTL_OFF = RING_BYTES, MISC_OFF = LDSCTL_OFF + 320;
constexpr int LDS_BYTES = 147456;
constexpr int SC_XH = 0;
constexpr int SC_XF = 20480;
constexpr int SC_HT = 53248;
constexpr int SC_CT = 73728;
constexpr int SC_CW = 94208;
constexpr int XHP = 136;
static_assert(SC_XH + 64 * XHP * 2 <= SC_XF && SC_XF + 32768 <= SC_HT && SC_HT + 64 * XHP * 2 <= SC_CT && SC_CT + 64 * XHP * 2 <= SC_CW && SC_CW + 2560 <= RING_BYTES, "scan LDS map");

#define GAS __attribute__((address_space(1)))
#define LAS __attribute__((address_space(3)))
typedef unsigned short bf16;
typedef unsigned v4u __attribute__((ext_vector_type(4)));
typedef unsigned v2u __attribute__((ext_vector_type(2)));
typedef float f32x4 __attribute__((ext_vector_type(4)));
typedef float f32x2 __attribute__((ext_vector_type(2)));
typedef short bf16x8 __attribute__((ext_vector_type(8)));
typedef GAS unsigned gu32;
#define RLX_AGENT __ATOMIC_RELAXED, __HIP_MEMORY_SCOPE_AGENT
#define LDS_WAIT() asm volatile("s_waitcnt lgkmcnt(0)" ::: "memory")
#define VM_WAIT() asm volatile("s_waitcnt vmcnt(0)" ::: "memory")
__device__ __forceinline__ unsigned f2bf(float f) { unsigned u = __builtin_bit_cast(unsigned, f); return (u + 0x7fffu + ((u >> 16) & 1u)) >> 16; }
__device__ __forceinline__ unsigned pk2(float lo, float hi) { return f2bf(lo) | (f2bf(hi) << 16); }
__device__ __forceinline__ float bf2f(unsigned short b) { return __uint_as_float(((unsigned)b) << 16); }

#define XB_TMO      128
#define XB_XCNT(j)  (256  + 64 * (j))
#define XB_XSUB(j)  (1280 + 64 * (j))
#define XB_XGEN(j)  (2304 + 64 * (j))
#define XB_TOP      3328
#define XB_TOPGEN   3392
#define XCD_BAR_WORDS 3456
#define XB_SPIN_CAP (1u << 18)

__device__ __forceinline__ unsigned xb_ld(unsigned* p)              { return __hip_atomic_load(p, __ATOMIC_RELAXED, __HIP_MEMORY_SCOPE_AGENT); }
__device__ __forceinline__ unsigned xb_add(unsigned* p, unsigned v) { return __hip_atomic_fetch_add(p, v, __ATOMIC_RELAXED, __HIP_MEMORY_SCOPE_AGENT); }
__device__ __forceinline__ unsigned xb_xcc_id() { return (unsigned)__builtin_amdgcn_s_getreg((3 << 11) | 20) & 0xFu; }
#define XB_SPIN(cond, bar) do { unsigned _sp = 0; while (cond) { __builtin_amdgcn_s_sleep(1); \
    if ((++_sp & 255u) == 0u) { if (xb_ld(&(bar)[XB_TMO])) break; if (_sp > XB_SPIN_CAP) { atomicAdd(&(bar)[XB_TMO], 1u); break; } } } } while (0)

struct XcdBarrier {
    unsigned* bar; unsigned x;
    volatile LAS unsigned* st;
};
__device__ __forceinline__ XcdBarrier xcd_barrier_post(unsigned* bar, volatile LAS unsigned* st) {
    XcdBarrier b; b.bar = bar; b.x = xb_xcc_id(); b.st = st;
    if (threadIdx.x == 0) (void)xb_add(&bar[XB_XCNT(b.x)], 1u);
    return b;
}
__device__ __forceinline__ void xcd_barrier_complete(unsigned* bar, unsigned x, unsigned& nloc, unsigned& nx) {
    const unsigned G = gridDim.x * gridDim.y * gridDim.z;
    unsigned sum, cnt, mine, sp = 0u;
    for (;;) {
        sum = 0u; cnt = 0u; mine = 0u;
#pragma unroll
        for (unsigned j = 0; j < 16; ++j) { const unsigned c = xb_ld(&bar[XB_XCNT(j)]); sum += c; cnt += (c > 0u) ? 1u : 0u; mine = (j == x) ? c : mine; }
        if (sum == G) break;
        __builtin_amdgcn_s_sleep(1);
        if ((++sp & 255u) == 0u) { if (xb_ld(&bar[XB_TMO])) break; if (sp > XB_SPIN_CAP) { atomicAdd(&bar[XB_TMO], 1u); break; } }
    }
    nloc = mine > 0u ? mine : 1u; nx = cnt > 0u ? cnt : 1u;
}
__device__ __forceinline__ void xcd_barrier(const XcdBarrier& b) {
    asm volatile("s_waitcnt vmcnt(0)" ::: "memory");
    __syncthreads();
    if (threadIdx.x == 0) {
        unsigned* bar = b.bar;
        __builtin_amdgcn_s_waitcnt(0);
        unsigned nloc = b.st[0], nx = b.st[1];
        if (nloc == 0u) { xcd_barrier_complete(bar, b.x, nloc, nx); b.st[0] = nloc; b.st[1] = nx; }
        const unsigned old = xb_add(&bar[XB_XSUB(b.x)], 1u);
        const unsigned gen = old / nloc;
        if (old + 1u == (gen + 1u) * nloc) {
            __builtin_amdgcn_fence(__ATOMIC_RELEASE, "agent");
            asm volatile("s_waitcnt vmcnt(0)" ::: "memory");
            const unsigned og = xb_add(&bar[XB_TOP], 1u);
            const unsigned tg = og / nx;
            if (og + 1u == (tg + 1u) * nx) xb_add(&bar[XB_TOPGEN], 1u);
            else XB_SPIN(xb_ld(&bar[XB_TOPGEN]) == tg, bar);
            __builtin_amdgcn_fence(__ATOMIC_ACQUIRE, "agent");
            xb_add(&bar[XB_XGEN(b.x)], 1u);
            asm volatile("s_waitcnt vmcnt(0)" ::: "memory");
        } else {
            XB_SPIN(xb_ld(&bar[XB_XGEN(b.x)]) == gen, bar);
            __builtin_amdgcn_fence(__ATOMIC_ACQUIRE, "agent");
            asm volatile("s_waitcnt vmcnt(0)" ::: "memory");
        }
    }
    __syncthreads();
}

constexpr int CW_BAR = 4096;
constexpr int PPL = 10;
struct Args { const float* in[23]; float* out; unsigned char* ws; int ph_lo, ph_hi; };
typedef const Args __attribute__((address_space(4)))* KArgs;
__device__ __forceinline__ KArgs kargs() { KArgs p = (KArgs)__builtin_amdgcn_kernarg_segment_ptr(); asm volatile("" : "+s"(p)); return p; }
enum { I_XP = 0, I_XS, I_SCA, I_SCB, I_SH, I_WIN, I_CAW, I_WOA, I_CBW, I_CBB, I_WR, I_BR, I_WI, I_BI, I_LAM, I_WOB, I_WO, I_NPM, I_NQM, I_NPF, I_NQF, I_WGU, I_WDN };

__device__ __forceinline__ float wave_sum(float v) {
#pragma unroll
    for (int o = 1; o < 64; o <<= 1) v += __shfl_xor(v, o);
    return v;
}

struct TrDesc { const float* W; const float* gk; bf16* WT; int Np, k0, n0, ldk, drow, dk; };
__device__ __forceinline__ void tr_load(const TrDesc& d, f32x4 (&va)[8], f32x4 (&vb)[8], f32x2 (&gg)[8], int lane) {
    const int lc = lane & 15, lr = lane >> 4;
#pragma unroll
    for (int i = 0; i < 8; ++i) { const int kk = 2 * (lr + 4 * i); const float* p = d.W + (size_t)(d.k0 + kk) * d.Np + d.n0 + 4 * lc;
        va[i] = *(const GAS f32x4*)p; vb[i] = *(const GAS f32x4*)(p + d.Np); }
#pragma unroll
    for (int i = 0; i < 8; ++i) { gg[i] = (f32x2){1.f, 1.f}; if (d.gk) gg[i] = *(const GAS f32x2*)(d.gk + d.k0 + 2 * (lr + 4 * i)); }
}
__device__ __forceinline__ void tr_store(const TrDesc& d, f32x4 (&va)[8], f32x4 (&vb)[8], const f32x2 (&gg)[8], LAS unsigned* T, int lane) {
    const int lc = lane & 15, lr = lane >> 4;
#pragma unroll
    for (int i = 0; i < 8; ++i) { va[i] = va[i] * gg[i].x; vb[i] = vb[i] * gg[i].y; }
#pragma unroll
    for (int i = 0; i < 8; ++i) { LAS unsigned* t = T + (lr + 4 * i) * 66 + 4 * lc;
        v2u a; a.x = pk2(va[i][0], vb[i][0]); a.y = pk2(va[i][1], vb[i][1]); v2u b; b.x = pk2(va[i][2], vb[i][2]); b.y = pk2(va[i][3], vb[i][3]);
        *(LAS v2u*)t = a; *(LAS v2u*)(t + 2) = b; }
    LDS_WAIT(); asm volatile("" ::: "memory");
    const int c = lane & 7;
#pragma unroll
    for (int j = 0; j < 8; ++j) { const int nn = (lane >> 3) + 8 * j; const LAS unsigned* sp = T + (4 * c) * 66 + nn;
        v4u o; o.x = sp[0]; o.y = sp[66]; o.z = sp[132]; o.w = sp[198];
        *(GAS v4u*)(d.WT + (size_t)(d.drow + nn) * d.ldk + d.dk + d.k0 + 8 * c) = o; }
    LDS_WAIT(); asm volatile("" ::: "memory");
}
__device__ __forceinline__ int map_in(int n) {
    if (n < 1024) return 2048 + n;
    if (n < 2048) { const int q = n - 1024; return 256 * (q >> 7) + (q & 127); }
    if (n < 3072) { const int q = n - 2048; return 256 * (q >> 7) + 128 + (q & 127); }
    if (n < 7168) return n;
    if (n < 9216) { const int q = n - 7168; return 7168 + 256 * (q >> 7) + (q & 127); }
    { const int q = n - 9216; return 7168 + 256 * (q >> 7) + 128 + (q & 127); }
}
__device__ __forceinline__ int map_gu(int n) {
    if (n < FF) return 256 * (n >> 7) + (n & 127);
    const int q = n - FF; return 256 * (q >> 7) + 128 + (q & 127);
}
constexpr int IT_IN = (DM / 64) * (NIN / 64), IT_OA = (DA / 64) * (DM / 64), IT_OB = (DB / 64) * (DM / 64), IT_O = (DM / 64) * (DM / 64), IT_GU = IT_IN, IT_DN = (FF / 64) * (DM / 64), IT_R = 16 * 4;
constexpr int IT_LAYER = IT_IN + IT_OA + IT_OB + IT_O + IT_GU + IT_DN + 2 * IT_R;

__device__ __forceinline__ TrDesc conv_desc(KArgs args, unsigned char* ws, int it) {
    const int l = it / IT_LAYER; int r = it - l * IT_LAYER;
    unsigned char* wl = ws + WS_W + (size_t)l * WL_STRIDE;
    TrDesc d; d.gk = nullptr; d.dk = 0; int kb, nb;
    if (r < IT_IN) { kb = r / (NIN / 64); nb = r % (NIN / 64); d.W = args->in[I_WIN] + (size_t)l * DM * NIN; d.Np = NIN; d.WT = (bf16*)(wl + WL_IN); d.ldk = DM; d.drow = map_in(64 * nb); d.gk = args->in[I_NPM] + (size_t)l * DM; }
    else if ((r -= IT_IN) < IT_OA) { kb = r / (DM / 64); nb = r % (DM / 64); d.W = args->in[I_WOA] + (size_t)l * DA * DM; d.Np = DM; d.WT = (bf16*)(wl + WL_AB); d.ldk = ZP; d.drow = 64 * nb; }
    else if ((r -= IT_OA) < IT_OB) { kb = r / (DM / 64); nb = r % (DM / 64); d.W = args->in[I_WOB] + (size_t)l * DB * DM; d.Np = DM; d.WT = (bf16*)(wl + WL_AB); d.ldk = ZP; d.drow = 64 * nb; d.dk = DA; }
    else if ((r -= IT_OB) < IT_O) { kb = r / (DM / 64); nb = r % (DM / 64); d.W = args->in[I_WO] + (size_t)l * DM * DM; d.Np = DM; d.WT = (bf16*)(wl + WL_O); d.ldk = DM; d.drow = 64 * nb; }
    else if ((r -= IT_O) < IT_GU) { kb = r / (NIN / 64); nb = r % (NIN / 64); d.W = args->in[I_WGU] + (size_t)l * DM * NIN; d.Np = NIN; d.WT = (bf16*)(wl + WL_GU); d.ldk = DM; d.drow = map_gu(64 * nb); d.gk = args->in[I_NPF] + (size_t)l * DM; }
    else if ((r -= IT_GU) < IT_DN) { kb = r / (DM / 64); nb = r % (DM / 64); d.W = args->in[I_WDN] + (size_t)l * FF * DM; d.Np = DM; d.WT = (bf16*)(wl + WL_DN); d.ldk = FF; d.drow = 64 * nb; }
    else { r -= IT_DN; const int isI = r >= IT_R; if (isI) r -= IT_R; const int hh = r >> 2; kb = (r >> 1) & 1; nb = r & 1;
        d.W = args->in[isI ? I_WI : I_WR] + (size_t)(l * 16 + hh) * 128 * 128; d.Np = 128; d.WT = (bf16*)(wl + WL_RI); d.ldk = 128; d.drow = hh * 256 + (isI ? 128 : 0) + 64 * nb; }
    d.k0 = 64 * kb; d.n0 = 64 * nb;
    return d;
}

__device__ __forceinline__ void thin_row(const bf16* yrow, const float* xin, bf16* xb, float* outf, float* rs, const float* g1, int lane) {
    f32x4 x[8];
    if (yrow) {
        f32x4 y[8]; float s = 0.f;
#pragma unroll
        for (int j = 0; j < 8; ++j) { const v2u w = ((const GAS v2u*)yrow)[lane + 64 * j]; y[j] = (f32x4){pg8::bflo(w.x), pg8::bfhi(w.x), pg8::bflo(w.y), pg8::bfhi(w.y)}; }
#pragma unroll
        for (int j = 0; j < 8; ++j) { const v2u w = ((const GAS v2u*)xb)[lane + 64 * j]; x[j] = (f32x4){pg8::bflo(w.x), pg8::bfhi(w.x), pg8::bflo(w.y), pg8::bfhi(w.y)}; }
#pragma unroll
        for (int j = 0; j < 8; ++j) s += (y[j].x * y[j].x + y[j].y * y[j].y) + (y[j].z * y[j].z + y[j].w * y[j].w);
        const float r1 = 1.0f / sqrtf(wave_sum(s) * (1.0f / DM) + EPS);
#pragma unroll
        for (int j = 0; j < 8; ++j) { const f32x4 g = ((const GAS f32x4*)g1)[lane + 64 * j]; x[j] += y[j] * r1 * g; }
    } else {
#pragma unroll
        for (int j = 0; j < 8; ++j) x[j] = ((const GAS f32x4*)xin)[lane + 64 * j];
    }
    if (outf) {
#pragma unroll
        for (int j = 0; j < 8; ++j) ((GAS f32x4*)outf)[lane + 64 * j] = x[j];
    } else {
        float s = 0.f;
#pragma unroll
        for (int j = 0; j < 8; ++j) { s += (x[j].x * x[j].x + x[j].y * x[j].y) + (x[j].z * x[j].z + x[j].w * x[j].w);
            v2u w; w.x = pk2(x[j].x, x[j].y); w.y = pk2(x[j].z, x[j].w); ((GAS v2u*)xb)[lane + 64 * j] = w; }
        const float r2 = 1.0f / sqrtf(wave_sum(s) * (1.0f / DM) + EPS);
        if (lane == 0) *rs = r2;
    }
}
__device__ __forceinline__ void convert_items(KArgs args, unsigned char* ws, LAS unsigned* T, int lo, int hi, int gw, int NGW, int lane, int K1 = (1 << 20), int gwf = -1, int NGWf = 1) {
    f32x4 a0[8], b0[8], a1[8], b1[8]; f32x2 g0[8], g1[8]; TrDesc d0 = {}, d1 = {};
    auto item = [&](int k) { return k < K1 ? lo + gw + k * NGW : (gwf >= 0 ? lo + K1 * NGW + gwf + (k - K1) * NGWf : hi); };
    int k = 0, it = item(0);
    if (it < hi) { d0 = conv_desc(args, ws, it); tr_load(d0, a0, b0, g0, lane); }
    while (it < hi) {
        int nx = item(k + 1);
        if (nx < hi) { d1 = conv_desc(args, ws, nx); tr_load(d1, a1, b1, g1, lane); }
        tr_store(d0, a0, b0, g0, T, lane);
        it = nx; ++k; if (it >= hi) break;
        nx = item(k + 1);
        if (nx < hi) { d0 = conv_desc(args, ws, nx); tr_load(d0, a0, b0, g0, lane); }
        tr_store(d1, a1, b1, g1, T, lane);
        it = nx; ++k;
    }
}
struct ThinIn { v2u y[8], x[8]; };
__device__ __forceinline__ void thin_load(ThinIn& I, const bf16* yrow, const bf16* xb, int lane) {
#pragma unroll
    for (int j = 0; j < 8; ++j) I.y[j] = ((const GAS v2u*)yrow)[lane + 64 * j];
#pragma unroll
    for (int j = 0; j < 8; ++j) I.x[j] = ((const GAS v2u*)xb)[lane + 64 * j];
}
__device__ __forceinline__ void thin_fin(const ThinIn& I, const f32x4 (&g)[8], bf16* xb, float* outf, float* rs, int lane) {
    f32x4 x[8], y[8]; float s = 0.f;
#pragma unroll
    for (int j = 0; j < 8; ++j) { y[j] = (f32x4){pg8::bflo(I.y[j].x), pg8::bfhi(I.y[j].x), pg8::bflo(I.y[j].y), pg8::bfhi(I.y[j].y)};
        x[j] = (f32x4){pg8::bflo(I.x[j].x), pg8::bfhi(I.x[j].x), pg8::bflo(I.x[j].y), pg8::bfhi(I.x[j].y)}; }
#pragma unroll
    for (int j = 0; j < 8; ++j) s += (y[j].x * y[j].x + y[j].y * y[j].y) + (y[j].z * y[j].z + y[j].w * y[j].w);
    const float r1 = 1.0f / sqrtf(wave_sum(s) * (1.0f / DM) + EPS);
#pragma unroll
    for (int j = 0; j < 8; ++j) x[j] += y[j] * r1 * g[j];
    if (outf) {
#pragma unroll
        for (int j = 0; j < 8; ++j) ((GAS f32x4*)outf)[lane + 64 * j] = x[j];
    } else {
        float s2 = 0.f;
#pragma unroll
        for (int j = 0; j < 8; ++j) { s2 += (x[j].x * x[j].x + x[j].y * x[j].y) + (x[j].z * x[j].z + x[j].w * x[j].w);
            v2u w; w.x = pk2(x[j].x, x[j].y); w.y = pk2(x[j].z, x[j].w); ((GAS v2u*)xb)[lane + 64 * j] = w; }
        const float r2 = 1.0f / sqrtf(wave_sum(s2) * (1.0f / DM) + EPS);
        if (lane == 0) *rs = r2;
    }
}
__device__ __forceinline__ void thin_rows(const bf16* Y, bf16* XB, float* X, float* RS, const float* g1, int gw, int NGW, int lane) {
    f32x4 g[8];
#pragma unroll
    for (int j = 0; j < 8; ++j) g[j] = ((const GAS f32x4*)g1)[lane + 64 * j];
    ThinIn A = {}, B = {};
    int m = gw;
    if (m < MPR) thin_load(A, Y + (size_t)m * DM, XB + (size_t)m * DM, lane);
    while (m < MPR) {
        int n = m + NGW;
        if (n < MPR) thin_load(B, Y + (size_t)n * DM, XB + (size_t)n * DM, lane);
        thin_fin(A, g, XB + (size_t)m * DM, X ? X + (size_t)m * DM : nullptr, RS + m, lane);
        m = n; if (m >= MPR) break;
        n = m + NGW;
        if (n < MPR) thin_load(A, Y + (size_t)n * DM, XB + (size_t)n * DM, lane);
        thin_fin(B, g, XB + (size_t)m * DM, X ? X + (size_t)m * DM : nullptr, RS + m, lane);
        m = n;
    }
}
template <int NPARTS>
__device__ __forceinline__ void thin_row_parts(LAS unsigned char* lds, const bf16* yrow, size_t pstride, bf16* xb, float* outf, float* rs, const float* g1, int tid) {
    LAS float* red = (LAS float*)lds;
    const int wave = tid >> 6, col = 4 * tid;
    v2u pw[NPARTS];
#pragma unroll
    for (int k = 0; k < NPARTS; ++k) pw[k] = *(const GAS v2u*)(yrow + (size_t)k * pstride + col);
    const v2u xw = *(const GAS v2u*)(xb + col); const f32x4 gg1 = *(const GAS f32x4*)(g1 + col);
    const f32x4 xr = {pg8::bflo(xw.x), pg8::bfhi(xw.x), pg8::bflo(xw.y), pg8::bfhi(xw.y)};
    f32x4 y = {0.f, 0.f, 0.f, 0.f};
#pragma unroll
    for (int k = 0; k < NPARTS; ++k) y += (f32x4){pg8::bflo(pw[k].x), pg8::bfhi(pw[k].x), pg8::bflo(pw[k].y), pg8::bfhi(pw[k].y)};
    float s = wave_sum((y.x * y.x + y.y * y.y) + (y.z * y.z + y.w * y.w));
    if ((tid & 63) == 0) red[wave] = s;
    LDS_WAIT(); __syncthreads();
    float tot = 0.f;
#pragma unroll
    for (int w = 0; w < 8; ++w) tot += red[w];
    const float r1 = 1.0f / sqrtf(tot * (1.0f / DM) + EPS);
    const f32x4 x = xr + y * r1 * gg1;
    if (outf) { *(GAS f32x4*)(outf + col) = x; }
    else {
        v2u wv; wv.x = pk2(x.x, x.y); wv.y = pk2(x.z, x.w); *(GAS v2u*)(xb + col) = wv;
        float s2 = wave_sum((x.x * x.x + x.y * x.y) + (x.z * x.z + x.w * x.w));
        if ((tid & 63) == 0) red[8 + wave] = s2;
        LDS_WAIT(); __syncthreads();
        float tot2 = 0.f;
#pragma unroll
        for (int w = 0; w < 8; ++w) tot2 += red[8 + w];
        if (tid == 0) *rs = 1.0f / sqrtf(tot2 * (1.0f / DM) + EPS);
    }
    __syncthreads();
}

template <int NPARTS>
__device__ __forceinline__ void thin_row_parts2(LAS unsigned char* lds, const bf16* slabs, size_t pstride, bf16* XBs, float* outs, float* RSs, const float* g1, int j0, int j1, bool has1, int tid) {
    LAS float* red = (LAS float*)lds;
    const int wave = tid >> 6, col = 4 * tid;
    const int jj[2] = {j0, has1 ? j1 : j0};
    v2u pw[2][NPARTS], xw[2];
#pragma unroll
    for (int r = 0; r < 2; ++r) {
#pragma unroll
        for (int k = 0; k < NPARTS; ++k) pw[r][k] = *(const GAS v2u*)(slabs + (size_t)jj[r] * DM + (size_t)k * pstride + col);
        xw[r] = *(const GAS v2u*)(XBs + (size_t)jj[r] * DM + col); }
    const f32x4 gg1 = *(const GAS f32x4*)(g1 + col);
    f32x4 y[2], x[2];
#pragma unroll
    for (int r = 0; r < 2; ++r) { y[r] = (f32x4){0.f, 0.f, 0.f, 0.f};
#pragma unroll
        for (int k = 0; k < NPARTS; ++k) y[r] += (f32x4){pg8::bflo(pw[r][k].x), pg8::bfhi(pw[r][k].x), pg8::bflo(pw[r][k].y), pg8::bfhi(pw[r][k].y)};
        const float s = wave_sum((y[r].x * y[r].x + y[r].y * y[r].y) + (y[r].z * y[r].z + y[r].w * y[r].w));
        if ((tid & 63) == 0) red[16 * r + wave] = s; }
    LDS_WAIT(); __syncthreads();
#pragma unroll
    for (int r = 0; r < 2; ++r) { float tot = 0.f;
#pragma unroll
        for (int w = 0; w < 8; ++w) tot += red[16 * r + w];
        const float r1 = 1.0f / sqrtf(tot * (1.0f / DM) + EPS);
        const f32x4 xr = {pg8::bflo(xw[r].x), pg8::bfhi(xw[r].x), pg8::bflo(xw[r].y), pg8::bfhi(xw[r].y)};
        x[r] = xr + y[r] * r1 * gg1; }
    if (outs) {
        *(GAS f32x4*)(outs + (size_t)j0 * DM + col) = x[0];
        if (has1) *(GAS f32x4*)(outs + (size_t)j1 * DM + col) = x[1];
    } else {
#pragma unroll
        for (int r = 0; r < 2; ++r) { if (r == 0 || has1) { v2u wv; wv.x = pk2(x[r].x, x[r].y); wv.y = pk2(x[r].z, x[r].w); *(GAS v2u*)(XBs + (size_t)jj[r] * DM + col) = wv; }
            const float s2 = wave_sum((x[r].x * x[r].x + x[r].y * x[r].y) + (x[r].z * x[r].z + x[r].w * x[r].w));
            if ((tid & 63) == 0) red[16 * r + 8 + wave] = s2; }
        LDS_WAIT(); __syncthreads();
        if (tid < 2 && (tid == 0 || has1)) { float tot2 = 0.f;
#pragma unroll
            for (int w = 0; w < 8; ++w) tot2 += red[16 * tid + 8 + w];
            RSs[jj[tid]] = 1.0f / sqrtf(tot2 * (1.0f / DM) + EPS); }
    }
    __syncthreads();
}

__device__ __forceinline__ void conva_item(KArgs args, const bf16* PROJ, bf16* Z, int l, int item) {
    const int cg = item & 127, r0 = 4 * (item >> 7), ch0 = 8 * cg;
    const float* cw = args->in[I_CAW] + (size_t)l * 3 * DA + ch0;
    float w0[8], w1[8], w2[8];
#pragma unroll
    for (int q = 0; q < 2; ++q) { const f32x4 a = *(const GAS f32x4*)(cw + 4 * q), b = *(const GAS f32x4*)(cw + DA + 4 * q), c = *(const GAS f32x4*)(cw + 2 * DA + 4 * q);
#pragma unroll
        for (int j = 0; j < 4; ++j) { w0[4 * q + j] = a[j]; w1[4 * q + j] = b[j]; w2[4 * q + j] = c[j]; } }
    float* out = args->out;
    v4u cxw[4], gw[4];
#pragma unroll
    for (int i = 0; i < 4; ++i) { cxw[i] = *(const GAS v4u*)(PROJ + (size_t)(r0 + i) * PP + C_CX + ch0); gw[i] = *(const GAS v4u*)(PROJ + (size_t)(r0 + i) * PP + C_ABG + ch0); }
    float p2[8], p1[8];
    const bool prompt = r0 < MPR; const int t0 = r0 & (TSEQ - 1), s = (r0 - MPR) >> 2;
    if (prompt) {
        if (t0 == 0) {
#pragma unroll
            for (int j = 0; j < 8; ++j) { p2[j] = 0.f; p1[j] = 0.f; }
        } else {
            const v4u a = *(const GAS v4u*)(PROJ + (size_t)(r0 - 2) * PP + C_CX + ch0), c = *(const GAS v4u*)(PROJ + (size_t)(r0 - 1) * PP + C_CX + ch0);
#pragma unroll
            for (int q = 0; q < 4; ++q) { p2[2 * q] = pg8::bflo(a[q]); p2[2 * q + 1] = pg8::bfhi(a[q]); p1[2 * q] = pg8::bflo(c[q]); p1[2 * q + 1] = pg8::bfhi(c[q]); }
        }
    } else {
        const float* st = args->in[I_SCA] + ((size_t)(l * NS + s) * 2) * DA + ch0;
        const f32x4 a0 = *(const GAS f32x4*)st, a1 = *(const GAS f32x4*)(st + 4), b0 = *(const GAS f32x4*)(st + DA), b1 = *(const GAS f32x4*)(st + DA + 4);
#pragma unroll
        for (int j = 0; j < 4; ++j) { p2[j] = a0[j]; p2[4 + j] = a1[j]; p1[j] = b0[j]; p1[4 + j] = b1[j]; }
    }
#pragma unroll
    for (int i = 0; i < 4; ++i) { const size_t r = (size_t)(r0 + i);
        float cur[8], g[8], z[8];
#pragma unroll
        for (int q = 0; q < 4; ++q) { cur[2 * q] = pg8::bflo(cxw[i][q]); cur[2 * q + 1] = pg8::bfhi(cxw[i][q]); g[2 * q] = pg8::bflo(gw[i][q]); g[2 * q + 1] = pg8::bfhi(gw[i][q]); }
#pragma unroll
        for (int j = 0; j < 8; ++j) { z[j] = g[j] * (w0[j] * p2[j] + w1[j] * p1[j] + w2[j] * cur[j]); p2[j] = p1[j]; p1[j] = cur[j]; }
        v4u o; o.x = pk2(z[0], z[1]); o.y = pk2(z[2], z[3]); o.z = pk2(z[4], z[5]); o.w = pk2(z[6], z[7]);
        *(GAS v4u*)(Z + r * ZP + ch0) = o;
        float* o2 = nullptr;
        if (prompt) { const int t = t0 + i; if (t >= TSEQ - 2) o2 = out + O_CAP + ((size_t)(l * NB + (r0 >> 11)) * 2 + (t - (TSEQ - 2))) * DA + ch0; }
        else if (i >= 2) o2 = out + O_CAS + ((size_t)(l * NS + s) * 2 + (i - 2)) * DA + ch0;
        if (o2) { *(GAS f32x4*)o2 = (f32x4){cur[0], cur[1], cur[2], cur[3]}; *(GAS f32x4*)(o2 + 4) = (f32x4){cur[4], cur[5], cur[6], cur[7]}; }
    }
}

struct ScanRegs { v4u w[5]; f32x4 sa[3], sb[3]; };
template <int MODE>
__device__ __forceinline__ void scan_load(ScanRegs& R, KArgs args, const bf16* PROJ, int l, int bq, int c, int h, int tid) {
    const int cgp = tid & 15, rq = tid >> 4, hc0 = 128 * h;
    if (MODE == 1) {
        const int row0 = bq * TSEQ + CHL * c;
#pragma unroll
        for (int e = 0; e < 5; ++e) { const int rr = 2 * rq - 3 + e;
            R.w[e] = (v4u){0u, 0u, 0u, 0u};
            if (c > 0 || rr >= 0) R.w[e] = *(const GAS v4u*)(PROJ + (size_t)(row0 + rr) * PP + C_BX + hc0 + 8 * cgp); }
    } else {
        const int sl = rq >> 1, tok0 = 2 * (rq & 1), row0 = MPR + 64 * bq + 4 * sl;
        const float* st = args->in[I_SCB] + ((size_t)(l * NS + 16 * bq + sl) * 3) * DB + hc0 + 8 * cgp;
#pragma unroll
        for (int e = 0; e < 5; ++e) { const int ti = tok0 - 3 + e;
            R.w[e] = (v4u){0u, 0u, 0u, 0u};
            if (ti >= 0) R.w[e] = *(const GAS v4u*)(PROJ + (size_t)(row0 + ti) * PP + C_BX + hc0 + 8 * cgp); }
#pragma unroll
        for (int e = 0; e < 3; ++e) { const int ti = tok0 - 3 + e;
            R.sa[e] = (f32x4){0.f, 0.f, 0.f, 0.f}; R.sb[e] = R.sa[e];
            if (ti < 0) { R.sa[e] = *(const GAS f32x4*)(st + (size_t)(3 + ti) * DB); R.sb[e] = *(const GAS f32x4*)(st + (size_t)(3 + ti) * DB + 4); } }
    }
}
struct ScanConst { bf16x8 Br[4], Bi[4]; float br, bi, lsl; };
__device__ __forceinline__ void scan_const(ScanConst& C, KArgs args, LAS unsigned char* lds, const bf16* WRI, int l, int h, int tid) {
    const int lane = tid & 63, wid = __builtin_amdgcn_readfirstlane(tid >> 6), fr = lane & 15, fq = lane >> 4, cgp = tid & 15, hc0 = 128 * h;
    const bf16* wri = WRI + (size_t)h * 256 * 128;
#pragma unroll
    for (int kk = 0; kk < 4; ++kk) { C.Br[kk] = *(const GAS bf16x8*)(wri + (size_t)(16 * wid + fr) * 128 + 32 * kk + 8 * fq); C.Bi[kk] = *(const GAS bf16x8*)(wri + (size_t)(128 + 16 * wid + fr) * 128 + 32 * kk + 8 * fq); }
    if (tid < 160) { const int k = tid >> 5, c4 = tid & 31;
        const float* src = (k < 4) ? args->in[I_CBW] + ((size_t)l * 4 + k) * DB + hc0 + 4 * c4 : args->in[I_CBB] + (size_t)l * DB + hc0 + 4 * c4;
        *(LAS f32x4*)((LAS float*)(lds + SC_CW) + k * 128 + 4 * c4) = *(const GAS f32x4*)src; }
    (void)cgp;
    const int mg = hc0 + 16 * wid + fr;
    C.br = args->in[I_BR][(size_t)l * DB + mg]; C.bi = args->in[I_BI][(size_t)l * DB + mg];
    const float lam = args->in[I_LAM][(size_t)l * DB + mg];
    C.lsl = (fminf(lam, 0.f) - log1pf(expf(-fabsf(lam)))) * (8.0f * 1.4426950408889634f);
}
template <int MODE>
__device__ __forceinline__ void scan_unit(KArgs args, LAS unsigned char* lds, ScanRegs& R, const ScanConst& C, const bf16* PROJ, bf16* Z, bf16* HL, bf16* CA, f32x2* SUM, int l, int bq, int c, int h, int nbq, int nc, int nh, int tid) {
    const int lane = tid & 63, wid = __builtin_amdgcn_readfirstlane(tid >> 6), fr = lane & 15, fq = lane >> 4;
    LAS bf16* XH = (LAS bf16*)(lds + SC_XH);
    LAS float* XF = (LAS float*)(lds + SC_XF);
    const int row0 = (MODE == 2) ? MPR + 64 * bq : bq * TSEQ + CHL * c;
    const int hc0 = 128 * h;
    float* out = args->out;
    {
        const int cgp = tid & 15, rq = tid >> 4;
        float u[5][8];
#pragma unroll
        for (int e = 0; e < 5; ++e) {
#pragma unroll
            for (int q = 0; q < 4; ++q) { u[e][2 * q] = pg8::bflo(R.w[e][q]); u[e][2 * q + 1] = pg8::bfhi(R.w[e][q]); } }
        if (MODE == 2) { const int tok0 = 2 * (rq & 1);
#pragma unroll
            for (int e = 0; e < 3; ++e) if (tok0 - 3 + e < 0) {
#pragma unroll
                for (int j = 0; j < 4; ++j) { u[e][j] = R.sa[e][j]; u[e][4 + j] = R.sb[e][j]; } } }
        float x0[8], x1[8];
#pragma unroll
        for (int j = 0; j < 8; ++j) { const LAS float* cwl = (const LAS float*)(lds + SC_CW) + 8 * cgp + j; const float w0 = cwl[0], w1 = cwl[128], w2 = cwl[256], w3 = cwl[384], b = cwl[512];
            x0[j] = b + w0 * u[0][j] + w1 * u[1][j] + w2 * u[2][j] + w3 * u[3][j];
            x1[j] = b + w0 * u[1][j] + w1 * u[2][j] + w2 * u[3][j] + w3 * u[4][j]; }
        const int r = 2 * rq;
        *(LAS f32x4*)(XF + r * 128 + 8 * cgp) = (f32x4){x0[0], x0[1], x0[2], x0[3]}; *(LAS f32x4*)(XF + r * 128 + 8 * cgp + 4) = (f32x4){x0[4], x0[5], x0[6], x0[7]};
        *(LAS f32x4*)(XF + (r + 1) * 128 + 8 * cgp) = (f32x4){x1[0], x1[1], x1[2], x1[3]}; *(LAS f32x4*)(XF + (r + 1) * 128 + 8 * cgp + 4) = (f32x4){x1[4], x1[5], x1[6], x1[7]};
        v4u p0, p1; p0.x = pk2(x0[0], x0[1]); p0.y = pk2(x0[2], x0[3]); p0.z = pk2(x0[4], x0[5]); p0.w = pk2(x0[6], x0[7]);
        p1.x = pk2(x1[0], x1[1]); p1.y = pk2(x1[2], x1[3]); p1.z = pk2(x1[4], x1[5]); p1.w = pk2(x1[6], x1[7]);
        *(LAS v4u*)(XH + r * XHP + 8 * cgp) = p0; *(LAS v4u*)(XH + (r + 1) * XHP + 8 * cgp) = p1;
        if (MODE == 1 && c == NCH - 1 && rq == 31) {
#pragma unroll
            for (int k = 0; k < 3; ++k) { float* o = out + O_CBP + ((size_t)(l * NB + bq) * 3 + k) * DB + hc0 + 8 * cgp;
                *(GAS f32x4*)o = (f32x4){u[2 + k][0], u[2 + k][1], u[2 + k][2], u[2 + k][3]}; *(GAS f32x4*)(o + 4) = (f32x4){u[2 + k][4], u[2 + k][5], u[2 + k][6], u[2 + k][7]}; } }
        if (MODE == 2 && (rq & 1)) { const int s = 16 * bq + (rq >> 1);
#pragma unroll
            for (int k = 0; k < 3; ++k) { float* o = out + O_CBS + ((size_t)(l * NS + s) * 3 + k) * DB + hc0 + 8 * cgp;
                *(GAS f32x4*)o = (f32x4){u[2 + k][0], u[2 + k][1], u[2 + k][2], u[2 + k][3]}; *(GAS f32x4*)(o + 4) = (f32x4){u[2 + k][4], u[2 + k][5], u[2 + k][6], u[2 + k][7]}; } }
    }
    if (nbq >= 0) scan_load<MODE>(R, args, PROJ, l, nbq, nc, nh, tid);
    LDS_WAIT(); __syncthreads();
    float av[4][4], bv[4][4];
    {
        f32x4 ar[4], ai[4];
#pragma unroll
        for (int mt = 0; mt < 4; ++mt) { ar[mt] = (f32x4){0.f, 0.f, 0.f, 0.f}; ai[mt] = (f32x4){0.f, 0.f, 0.f, 0.f}; }
#pragma unroll
        for (int mt = 0; mt < 4; ++mt)
#pragma unroll
            for (int kk = 0; kk < 4; ++kk) { const bf16x8 a = *(const LAS bf16x8*)(XH + (16 * mt + fr) * XHP + 32 * kk + 8 * fq);
                ar[mt] = __builtin_amdgcn_mfma_f32_16x16x32_bf16(a, C.Br[kk], ar[mt], 0, 0, 0); ai[mt] = __builtin_amdgcn_mfma_f32_16x16x32_bf16(a, C.Bi[kk], ai[mt], 0, 0, 0); }
        const int mch = 16 * wid + fr;
#pragma unroll
        for (int mt = 0; mt < 4; ++mt)
#pragma unroll
            for (int j = 0; j < 4; ++j) { const int r = 16 * mt + 4 * fq + j;
                const float rr = pg8::fsig(ar[mt][j] + C.br), ii = pg8::fsig(ai[mt][j] + C.bi);
                const float l2 = rr * C.lsl;
                const float a = __builtin_amdgcn_exp2f(l2);
                const float y = l2 * 1.3862943611198906f;
                float em = -y * (1.0f + y * (0.5f + y * (0.16666667f + y * (0.041666668f + y * (0.008333334f + y * 0.0013888889f)))));
                em = (y > -0.35f) ? em : (1.0f - a * a);
                const float mult = __builtin_amdgcn_sqrtf(fmaxf(em, 0.f));
                av[mt][j] = a; bv[mt][j] = mult * ii * XF[r * 128 + mch]; }
    }
    LAS bf16* HT = (LAS bf16*)(lds + SC_HT);
    LAS bf16* CT = (LAS bf16*)(lds + SC_CT);
    const int mchn = 16 * wid + fr, gch = hc0 + mchn;
    if (MODE == 1) {
        float pa[4][4], pb[4][4], Ae[4], Be[4], At[4], Bt[4];
#pragma unroll
        for (int mt = 0; mt < 4; ++mt) { float A = 1.f, B = 0.f;
#pragma unroll
            for (int j = 0; j < 4; ++j) { B = av[mt][j] * B + bv[mt][j]; A *= av[mt][j]; pa[mt][j] = A; pb[mt][j] = B; }
            float Au = __shfl_up(A, 16), Bu = __shfl_up(B, 16); if (fq >= 1) { B = A * Bu + B; A = A * Au; }
            Au = __shfl_up(A, 32); Bu = __shfl_up(B, 32); if (fq >= 2) { B = A * Bu + B; A = A * Au; }
            Ae[mt] = __shfl_up(A, 16); Be[mt] = __shfl_up(B, 16); if (fq == 0) { Ae[mt] = 1.f; Be[mt] = 0.f; }
            At[mt] = __shfl(A, fr + 48); Bt[mt] = __shfl(B, fr + 48); }
        float Hc = 0.f, Ac = 1.f;
#pragma unroll
        for (int mt = 0; mt < 4; ++mt) { const float Hin = Ae[mt] * Hc + Be[mt], Ain = Ae[mt] * Ac;
#pragma unroll
            for (int j = 0; j < 4; ++j) { const int r = 16 * mt + 4 * fq + j;
                HT[r * XHP + mchn] = (bf16)f2bf(pa[mt][j] * Hin + pb[mt][j]); CT[r * XHP + mchn] = (bf16)f2bf(pa[mt][j] * Ain); }
            Hc = At[mt] * Hc + Bt[mt]; Ac = At[mt] * Ac; }
        if (fq == 0) SUM[((size_t)bq * NCH + c) * DB + gch] = (f32x2){Ac, Hc};
    } else {
#pragma unroll
        for (int mt = 0; mt < 4; ++mt) { const int s = 16 * bq + 4 * mt + fq;
            float H = args->in[I_SH][(size_t)(l * NS + s) * DB + gch];
#pragma unroll
            for (int j = 0; j < 4; ++j) { const int r = 16 * mt + 4 * fq + j; H = av[mt][j] * H + bv[mt][j]; HT[r * XHP + mchn] = (bf16)f2bf(H); }
            out[O_HS + (size_t)(l * NS + s) * DB + gch] = H; }
    }
    LDS_WAIT(); __syncthreads();
#pragma unroll
    for (int it = 0; it < 2; ++it) { const int q = tid + it * (NWAVES * 64), r = q >> 4, cc = q & 15; const size_t grow = (size_t)(row0 + r);
        const v4u hw = *(const LAS v4u*)(HT + r * XHP + 8 * cc);
        if (MODE == 1) {
            *(GAS v4u*)(HL + grow * DM + hc0 + 8 * cc) = hw;
            *(GAS v4u*)(CA + grow * DM + hc0 + 8 * cc) = *(const LAS v4u*)(CT + r * XHP + 8 * cc);
        } else {
            const v4u g = *(const GAS v4u*)(PROJ + grow * PP + C_BG + hc0 + 8 * cc);
            v4u o; o.x = pk2(pg8::bflo(hw.x) * pg8::bflo(g.x), pg8::bfhi(hw.x) * pg8::bfhi(g.x)); o.y = pk2(pg8::bflo(hw.y) * pg8::bflo(g.y), pg8::bfhi(hw.y) * pg8::bfhi(g.y));
            o.z = pk2(pg8::bflo(hw.z) * pg8::bflo(g.z), pg8::bfhi(hw.z) * pg8::bfhi(g.z)); o.w = pk2(pg8::bflo(hw.w) * pg8::bflo(g.w), pg8::bfhi(hw.w) * pg8::bfhi(g.w));
            *(GAS v4u*)(Z + grow * ZP + DA + hc0 + 8 * cc) = o;
        } }
}
__device__ __forceinline__ void fix_unit(KArgs args, LAS unsigned char* lds, const bf16* PROJ, bf16* Z, const bf16* HL, const bf16* CA, const f32x2* SUM, int l, int b, int c, int qd, int tid) {
    LAS float* HIN = (LAS float*)lds;
    const int ch0 = 512 * qd;
    const int row0 = b * TSEQ + CHL * c;
    v4u hw[8], cw[8], gw[8];
#pragma unroll
    for (int it = 0; it < 8; ++it) { const int q = tid + it * (NWAVES * 64), r = q >> 6, cc = q & 63; const size_t grow = (size_t)(row0 + r); const int col = ch0 + 8 * cc;
        hw[it] = *(const GAS v4u*)(HL + grow * DM + col); cw[it] = *(const GAS v4u*)(CA + grow * DM + col); gw[it] = *(const GAS v4u*)(PROJ + grow * PP + C_BG + col); }
    {
        float H = 0.f;
#pragma unroll
        for (int q0 = 0; q0 < 32; q0 += 8) { f32x2 sg[8];
#pragma unroll
            for (int q = 0; q < 8; ++q) { sg[q] = (f32x2){1.f, 0.f}; if (q0 + q < c) sg[q] = SUM[((size_t)b * NCH + q0 + q) * DB + ch0 + tid]; }
#pragma unroll
            for (int q = 0; q < 8; ++q) H = sg[q].x * H + sg[q].y; }
        HIN[tid] = H;
    }
    LDS_WAIT(); __syncthreads();
#pragma unroll
    for (int it = 0; it < 8; ++it) { const int q = tid + it * (NWAVES * 64), r = q >> 6, cc = q & 63; const size_t grow = (size_t)(row0 + r); const int col = ch0 + 8 * cc;
        const f32x4 i0 = *(const LAS f32x4*)(HIN + 8 * cc), i1 = *(const LAS f32x4*)(HIN + 8 * cc + 4);
        float hh[8];
        hh[0] = pg8::bflo(hw[it].x) + pg8::bflo(cw[it].x) * i0.x; hh[1] = pg8::bfhi(hw[it].x) + pg8::bfhi(cw[it].x) * i0.y; hh[2] = pg8::bflo(hw[it].y) + pg8::bflo(cw[it].y) * i0.z; hh[3] = pg8::bfhi(hw[it].y) + pg8::bfhi(cw[it].y) * i0.w;
        hh[4] = pg8::bflo(hw[it].z) + pg8::bflo(cw[it].z) * i1.x; hh[5] = pg8::bfhi(hw[it].z) + pg8::bfhi(cw[it].z) * i1.y; hh[6] = pg8::bflo(hw[it].w) + pg8::bflo(cw[it].w) * i1.z; hh[7] = pg8::bfhi(hw[it].w) + pg8::bfhi(cw[it].w) * i1.w;
        v4u o; o.x = pk2(hh[0] * pg8::bflo(gw[it].x), hh[1] * pg8::bfhi(gw[it].x)); o.y = pk2(hh[2] * pg8::bflo(gw[it].y), hh[3] * pg8::bfhi(gw[it].y));
        o.z = pk2(hh[4] * pg8::bflo(gw[it].z), hh[5] * pg8::bfhi(gw[it].z)); o.w = pk2(hh[6] * pg8::bflo(gw[it].w), hh[7] * pg8::bfhi(gw[it].w));
        *(GAS v4u*)(Z + grow * ZP + DA + col) = o;
        if (c == NCH - 1 && r == CHL - 1) { float* o2 = args->out + O_HP + (size_t)(l * NB + b) * DB + col;
            *(GAS f32x4*)o2 = (f32x4){hh[0], hh[1], hh[2], hh[3]}; *(GAS f32x4*)(o2 + 4) = (f32x4){hh[4], hh[5], hh[6], hh[7]}; }
    }
    __syncthreads();
}

__global__ void __launch_bounds__(NWAVES * 64, 2) fwd(Args args_by_value) {
    extern __shared__ __attribute__((aligned(16))) unsigned char lds_raw[];
    LAS unsigned char* lds = (LAS unsigned char*)lds_raw;
    volatile LAS unsigned* MISC = (volatile LAS unsigned*)(lds + MISC_OFF);
    const int tid = threadIdx.x, lane = tid & 63, wave = __builtin_amdgcn_readfirstlane(tid >> 6);
    const int G = gridDim.x, bx = blockIdx.x;
    const int vcu = (G % 8 == 0) ? (bx % 8) * (G / 8) + bx / 8 : bx;
    int lo, hi; unsigned* barw;
    { KArgs args = kargs(); lo = args->ph_lo; hi = args->ph_hi; barw = (unsigned*)(args->ws + WS_CTL) + CW_BAR; }
    for (int u = tid; u < (LDS_BYTES - LDSCTL_OFF) / 4; u += NWAVES * 64) ((LAS unsigned*)(lds + LDSCTL_OFF))[u] = 0u;
    __syncthreads();
    XcdBarrier bar; bar.bar = barw; bar.x = 0; bar.st = nullptr;
    if (hi - lo > 1) bar = xcd_barrier_post(barw, MISC + 8);
#ifndef PHMASK
#define PHMASK 0x7ff
#endif
#define RUN(p) (lo <= (p) && (p) < hi)
#define EN(k) ((PHMASK >> (k)) & 1)
#ifndef DUPMASK
#define DUPMASK 0
#endif
#define REP(k) for (int rep_ = 0; rep_ < 1 + ((DUPMASK >> (k)) & 1); ++rep_)
#ifndef BARX
#define BARX 0
#endif
#define SEAM(p) do { if (RUN(p) && RUN((p) + 1)) { xcd_barrier(bar); for (int bx_ = 0; bx_ < BARX; ++bx_) xcd_barrier(bar); } } while (0)
#define PH_BEGIN() KArgs args = kargs(); unsigned char* ws = args->ws; \
    bf16* XB = (bf16*)(ws + WS_U); float* RS = (float*)(ws + WS_RS); bf16* PROJ = (bf16*)(ws + WS_PROJ); bf16* Z = (bf16*)(ws + WS_Z); \
    float* TMP = (float*)(ws + WS_TMP); bf16* MRG = (bf16*)(ws + WS_MRG); float* Y32 = (float*)(ws + WS_Y32); bf16* HM = (bf16*)(ws + WS_HM); \
    f32x2* SUM = (f32x2*)(ws + WS_SUM); float* PARTS = (float*)(ws + WS_PARTS); float* X = args->out + O_X; \
    (void)XB; (void)RS; (void)PROJ; (void)Z; (void)TMP; (void)MRG; (void)Y32; (void)HM; (void)SUM; (void)PARTS; (void)X
    const int NGW = G * NWAVES;

    if (EN(0) && RUN(0)) REP(0) {
        PH_BEGIN(); const int gw = vcu * NWAVES + wave;
        LAS unsigned* T = (LAS unsigned*)(lds + RING_OFF + wave * 8448);
        convert_items(args, ws, T, 0, IT_LAYER, gw, NGW, lane);
        for (int m = gw; m < M; m += NGW) {
            const float* xin = (m < MPR) ? args->in[I_XP] + (size_t)m * DM : args->in[I_XS] + (size_t)(m - MPR) * DM;
            thin_row(nullptr, xin, XB + (size_t)m * DM, nullptr, RS + m, nullptr, lane);
        }
    }
    SEAM(0);

    for (int l = 0; l < NL; ++l) {
        const int pb = 1 + PPL * l;
#define OPAQUE_TID() int tid_o = threadIdx.x; asm volatile("" : "+v"(tid_o)); const int lane_o = tid_o & 63, wave_o = __builtin_amdgcn_readfirstlane(tid_o >> 6), gw_o = vcu * NWAVES + wave_o
        if (EN(1) && RUN(pb + 0)) REP(1) {
            PH_BEGIN(); unsigned char* wl = ws + WS_W + (size_t)l * WL_STRIDE; (void)wl;
            pg8::Gemm g{XB, (const bf16*)(wl + WL_IN), DM}; pg8::OrderFull S; S.init(M, NIN, DM, G, bx);
            pg8::EpiG1 E{PROJ, (pg8::u32x4*)Y32, RS};
            pg8::gemm_phase<pg8::EpiG1, pg8::OrderFull, true, true>(lds + RING_OFF, g, S, E);
        }
        SEAM(pb + 0);
        if (EN(2) && RUN(pb + 1)) REP(2) {
            PH_BEGIN(); unsigned char* wl = ws + WS_W + (size_t)l * WL_STRIDE;
            bf16* HL = (bf16*)TMP; bf16* CA = HL + (size_t)M * DM;
            constexpr int NPU = NB * NCH * 16, NSU = (MSA / 64) * 16;
            const int CK1 = (G > NSU) ? 7 : (1 << 20);
            OPAQUE_TID(); (void)lane_o; (void)gw_o;
            if ((vcu & 1) && l + 1 < NL) { convert_items(args, ws, (LAS unsigned*)(lds + RING_OFF + wave_o * 8448), (l + 1) * IT_LAYER, (l + 2) * IT_LAYER, gw_o, NGW, lane_o, CK1, (vcu < G - NSU) ? gw_o : -1, (G - NSU) * NWAVES); __syncthreads(); }
            {
                ScanConst C = {}; ScanRegs R = {}; int hprev = -1;
                if (vcu < NPU) { const int h = vcu & 15, bc = vcu >> 4; scan_load<1>(R, args, PROJ, l, bc / NCH, bc % NCH, h, tid_o); }
                for (int u = vcu; u < NPU; u += G) { const int h = u & 15, bc = u >> 4, c = bc % NCH, b = bc / NCH;
                    if (h != hprev) { __syncthreads(); scan_const(C, args, lds, (const bf16*)(wl + WL_RI), l, h, tid_o); LDS_WAIT(); __syncthreads(); hprev = h; }
                    const int un = u + G; const bool hn = un < NPU; const int nbc = un >> 4;
                    scan_unit<1>(args, lds, R, C, PROJ, Z, HL, CA, SUM, l, b, c, h, hn ? nbc / NCH : -1, nbc % NCH, un & 15, tid_o); }
            }
            for (int v = G - 1 - vcu; v < NSU; v += G) { const int h = v & 15, grp = v >> 4;
                int tid_s = tid_o; asm volatile("" : "+v"(tid_s));
                ScanConst C = {}; ScanRegs R = {}; __syncthreads(); scan_const(C, args, lds, (const bf16*)(wl + WL_RI), l, h, tid_s); LDS_WAIT(); __syncthreads(); scan_load<2>(R, args, PROJ, l, grp, 0, h, tid_s);
                scan_unit<2>(args, lds, R, C, PROJ, Z, HL, CA, SUM, l, grp, 0, h, -1, 0, 0, tid_s); }
            { int tid_c = tid_o; asm volatile("" : "+v"(tid_c));
              for (int it = vcu * (NWAVES * 64) + tid_c; it < (M / 4) * 128; it += G * (NWAVES * 64)) conva_item(args, PROJ, Z, l, it); }
            if (!(vcu & 1) && l + 1 < NL) { int tid_v = tid_o; asm volatile("" : "+v"(tid_v)); __syncthreads();
                convert_items(args, ws, (LAS unsigned*)(lds + RING_OFF + __builtin_amdgcn_readfirstlane(tid_v >> 6) * 8448), (l + 1) * IT_LAYER, (l + 2) * IT_LAYER, vcu * NWAVES + __builtin_amdgcn_readfirstlane(tid_v >> 6), NGW, tid_v & 63, CK1, (vcu < G - NSU) ? vcu * NWAVES + __builtin_amdgcn_readfirstlane(tid_v >> 6) : -1, (G - NSU) * NWAVES); }
        }
        SEAM(pb + 1);
        if (EN(3) && RUN(pb + 2)) REP(3) {
            PH_BEGIN();
            const bf16* HL = (const bf16*)TMP; const bf16* CA = HL + (size_t)M * DM;
            OPAQUE_TID(); (void)lane_o; (void)gw_o;
            for (int u = vcu; u < NB * NCH * 4; u += G) { const int qd = u & 3, bc = u >> 2, c = bc % NCH, b = bc / NCH;
                fix_unit(args, lds, PROJ, Z, HL, CA, SUM, l, b, c, qd, tid_o); }
        }
        SEAM(pb + 2);
        if (EN(4) && RUN(pb + 3)) REP(4) {
            PH_BEGIN(); unsigned char* wl = ws + WS_W + (size_t)l * WL_STRIDE; (void)wl;
            pg8::Gemm g{Z, (const bf16*)(wl + WL_AB), ZP}; pg8::OrderG3 S; S.init(G, bx);
            pg8::EpiG3 E{(const pg8::u32x4*)Y32, MRG, (bf16*)PARTS};
            pg8::gemm_phase<pg8::EpiG3, pg8::OrderG3, true, true>(lds + RING_OFF, g, S, E);
        }
        SEAM(pb + 3);
        if (EN(5) && RUN(pb + 4)) REP(5) {
            PH_BEGIN(); unsigned char* wl = ws + WS_W + (size_t)l * WL_STRIDE; (void)wl;
            OPAQUE_TID();
            for (int it = gw_o; it < MSA * 4; it += NGW) { const int r = it >> 2, q = it & 3;
                const bf16* p = (const bf16*)PARTS + (size_t)r * DM + 512 * q + 8 * lane_o;
                v4u pw[12];
#pragma unroll
                for (int k = 0; k < 12; ++k) pw[k] = *(const GAS v4u*)(p + (size_t)k * MSA * DM);
                float a[8] = {0.f, 0.f, 0.f, 0.f, 0.f, 0.f, 0.f, 0.f};
#pragma unroll
                for (int k = 0; k < 12; ++k) { a[0] += pg8::bflo(pw[k].x); a[1] += pg8::bfhi(pw[k].x); a[2] += pg8::bflo(pw[k].y); a[3] += pg8::bfhi(pw[k].y); a[4] += pg8::bflo(pw[k].z); a[5] += pg8::bfhi(pw[k].z); a[6] += pg8::bflo(pw[k].w); a[7] += pg8::bfhi(pw[k].w); }
                v4u o; o.x = pk2(a[0], a[1]); o.y = pk2(a[2], a[3]); o.z = pk2(a[4], a[5]); o.w = pk2(a[6], a[7]);
                *(GAS v4u*)(MRG + (size_t)(MPR + r) * DM + 512 * q + 8 * lane_o) = o; }
        }
        SEAM(pb + 4);
        if (EN(6) && RUN(pb + 5)) REP(6) {
            PH_BEGIN(); unsigned char* wl = ws + WS_W + (size_t)l * WL_STRIDE; (void)wl;
            pg8::Gemm g{MRG, (const bf16*)(wl + WL_O), DM}; pg8::OrderTail S; S.init(DM, 8, 0, G, bx);
            pg8::EpiY E{(bf16*)Y32, (bf16*)PARTS};
            pg8::gemm_phase<pg8::EpiY, pg8::OrderTail, true, true>(lds + RING_OFF, g, S, E);
        }
        SEAM(pb + 5);
        if (EN(7) && RUN(pb + 6)) {
            PH_BEGIN();
            OPAQUE_TID();
            const float* g1 = args->in[I_NQM] + (size_t)l * DM;
            thin_rows((const bf16*)Y32, XB, nullptr, RS, g1, gw_o, NGW, lane_o);
            for (int j = vcu; j < MSA; j += 2 * G)
                thin_row_parts2<8>(lds, (const bf16*)PARTS, (size_t)MSA * DM, XB + (size_t)MPR * DM, nullptr, RS + MPR, g1, j, j + G, j + G < MSA, tid_o);
        }
        SEAM(pb + 6);
        if (EN(8) && RUN(pb + 7)) REP(8) {
            PH_BEGIN(); unsigned char* wl = ws + WS_W + (size_t)l * WL_STRIDE; (void)wl;
            pg8::Gemm g{XB, (const bf16*)(wl + WL_GU), DM}; pg8::OrderFull S; S.init(M, NIN, DM, G, bx);
            pg8::EpiG5 E{HM, RS};
            pg8::gemm_phase<pg8::EpiG5, pg8::OrderFull, true, true>(lds + RING_OFF, g, S, E);
        }
        SEAM(pb + 7);
        if (EN(9) && RUN(pb + 8)) REP(9) {
            PH_BEGIN(); unsigned char* wl = ws + WS_W + (size_t)l * WL_STRIDE; (void)wl;
            pg8::Gemm g{HM, (const bf16*)(wl + WL_DN), FF}; pg8::OrderTail S; S.init(FF, 16, 12, G, bx);
            pg8::EpiY E{(bf16*)Y32, (bf16*)PARTS};
            pg8::gemm_phase<pg8::EpiY, pg8::OrderTail, true, true>(lds + RING_OFF, g, S, E);
        }
        SEAM(pb + 8);
        if (EN(10) && RUN(pb + 9)) {
            PH_BEGIN();
            OPAQUE_TID();
            const bool lastl = (l == NL - 1);
            const float* g1 = args->in[I_NQF] + (size_t)l * DM;
            thin_rows((const bf16*)Y32, XB, lastl ? X : nullptr, RS, g1, gw_o, NGW, lane_o);
            for (int j = vcu; j < MSA; j += 2 * G)
                thin_row_parts2<16>(lds, (const bf16*)PARTS, (size_t)MSA * DM, XB + (size_t)MPR * DM, lastl ? X + (size_t)MPR * DM : nullptr, RS + MPR, g1, j, j + G, j + G < MSA, tid_o);
        }
        SEAM(pb + 9);
    }
#undef RUN
#undef SEAM
}

constexpr int NPHASES = 1 + PPL * NL;
extern "C" void kernel_launch(void* const* d_in, const int* in_sizes, int n_in, void* d_out, int out_size, void* d_ws, size_t ws_size, hipStream_t stream) {
    static int grid = 0;
    if (grid == 0) {
        if (n_in != 23 || ws_size < WS_END) { fprintf(stderr, "kernel_launch: unexpected shapes: n_in %d out %d ws %zu (need %zu)\n", n_in, out_size, ws_size, (size_t)WS_END); grid = -1; return; }
        int dev = 0, cus = 0, per_cu = 0;
        if (hipGetDevice(&dev) != hipSuccess || hipDeviceGetAttribute(&cus, hipDeviceAttributeMultiprocessorCount, dev) != hipSuccess) { grid = -1; return; }
        if (hipFuncSetAttribute((const void*)fwd, hipFuncAttributeMaxDynamicSharedMemorySize, LDS_BYTES) != hipSuccess) { fprintf(stderr, "kernel_launch: hipFuncSetAttribute failed\n"); grid = -1; return; }
        if (hipOccupancyMaxActiveBlocksPerMultiprocessor(&per_cu, (const void*)fwd, NWAVES * 64, LDS_BYTES) != hipSuccess || per_cu < 1)
            fprintf(stderr, "kernel_launch: note: occupancy query reports %d workgroups per CU\n", per_cu);
        (void)hipGetLastError();
        grid = cus;
    }
    if (grid < 0) return;
    if (hipMemsetAsync((char*)d_ws + WS_CTL, 0, CTL_ZERO_BYTES, stream) != hipSuccess) { fprintf(stderr, "kernel_launch: memset failed\n"); return; }
    Args a{};
    for (int i = 0; i < 23; ++i) a.in[i] = (const float*)d_in[i];
    a.out = (float*)d_out; a.ws = (unsigned char*)d_ws;
#if MK_PER_PHASE
    for (int p = 0; p < NPHASES; ++p) { a.ph_lo = p; a.ph_hi = p + 1; hipLaunchKernelGGL(fwd, dim3(grid), dim3(NWAVES * 64), LDS_BYTES, stream, a); }
#else
    a.ph_lo = 0; a.ph_hi = NPHASES;
    hipLaunchKernelGGL(fwd, dim3(grid), dim3(NWAVES * 64), LDS_BYTES, stream, a);
#endif
    const hipError_t le = hipPeekAtLastError();
    if (le != hipSuccess) fprintf(stderr, "kernel_launch: launch failed: %s\n", hipGetErrorName(le));
}
```

```cpp
#include <hip/hip_runtime.h>
#include <cstdio>
#include <cstdint>

#ifndef MK_PER_PHASE
#define MK_PER_PHASE 0
#endif

constexpr int DM = 2048, DA = 1024, DB = 2048, FF = 5632, NL = 4;
constexpr int MPR = 8192, MSA = 512, M = MPR + MSA;
constexpr int TSEQ = 2048, NB = 4, NS = 128;
constexpr int NIN = 11264;
constexpr int PP = 10240;
constexpr int C_CX = 0, C_ABG = 1024, C_BX = 2048, C_BG = 4096, C_GA = 6144, C_GB = 8192;
constexpr int ZP = 3072;
constexpr float EPS = 1e-6f;
constexpr int NCH = 32, CHL = 64;

constexpr size_t MiB = 1u << 20;
constexpr size_t WS_CTL = 0, CTL_ZERO_BYTES = 64 * 1024;
constexpr size_t WL_IN = 0, WL_AB = 44 * MiB, WL_O = 56 * MiB, WL_GU = 64 * MiB, WL_DN = 108 * MiB, WL_RI = 130 * MiB, WL_STRIDE = 131 * MiB;
constexpr size_t WS_W = 1 * MiB;
constexpr size_t WS_U = WS_W + NL * WL_STRIDE;
constexpr size_t WS_V = WS_U + 34 * MiB;
constexpr size_t WS_PROJ = WS_V + 34 * MiB;
constexpr size_t WS_Z = WS_PROJ + 170 * MiB;
constexpr size_t WS_TMP = WS_Z + 51 * MiB;
constexpr size_t WS_MRG = WS_TMP + 68 * MiB;
constexpr size_t WS_Y32 = WS_MRG + 34 * MiB;
constexpr size_t WS_HM = WS_Y32 + 68 * MiB;
constexpr size_t WS_SUM = WS_HM + 94 * MiB;
constexpr size_t WS_PARTS = WS_SUM + 2 * MiB;
constexpr size_t WS_RS = WS_PARTS + 64 * MiB;
constexpr size_t WS_END = WS_RS + 1 * MiB;
static_assert((size_t)M * PP * 2 <= 170 * MiB && (size_t)M * ZP * 2 <= 51 * MiB && (size_t)M * DM * 4 <= 68 * MiB && (size_t)M * FF * 2 <= 94 * MiB && (size_t)M * DM * 2 <= 34 * MiB, "ws map");
static_assert((size_t)NIN * DM * 2 <= 44 * MiB && (size_t)DM * ZP * 2 <= 12 * MiB && (size_t)DM * FF * 2 <= 22 * MiB, "weight map");

constexpr size_t O_X = 0;
constexpr size_t O_CAP = (size_t)M * DM;
constexpr size_t O_CBP = O_CAP + (size_t)NL * NB * 2 * DA;
constexpr size_t O_HP = O_CBP + (size_t)NL * NB * 3 * DB;
constexpr size_t O_CAS = O_HP + (size_t)NL * NB * DB;
constexpr size_t O_CBS = O_CAS + (size_t)NL * NS * 2 * DA;
constexpr size_t O_HS = O_CBS + (size_t)NL * NS * 3 * DB;
constexpr size_t O_END = O_HS + (size_t)NL * NS * DB;

namespace pg8 {
#define PG8_LAS __attribute__((address_space(3)))
typedef unsigned short bf16_t;
typedef short bf16x8 __attribute__((ext_vector_type(8)));
typedef float f32x4 __attribute__((ext_vector_type(4)));
typedef unsigned u32x4 __attribute__((ext_vector_type(4)));
constexpr int BM = 256, BK = 64, HALF = 128, HTB = HALF * BK * 2, STAGE_BYTES = 8 * HTB, NXCD = 8, WGM = 8;

__host__ __device__ __forceinline__ int lds_byte(int r, int c) { const int st = (r >> 4) * 2 + (c >> 5), rr = r & 15, cc = c & 31, ob = rr * 64 + cc * 2; return st * 1024 + (ob ^ (((ob >> 9) & 1) << 5)); }
__host__ __device__ __forceinline__ void stage_rc(int b, int& R, int& C) { const int st = b / 1024, sb = b % 1024, swz = sb ^ (((sb >> 9) & 1) << 5); R = (st >> 1) * 16 + swz / 64; C = (st & 1) * 32 + (swz % 64) / 2; }
__host__ __device__ __forceinline__ int perm32(int rho) { const int n = rho >> 4, i = rho & 15; return 8 * (i >> 2) + 4 * n + (i & 3); }

struct Unit { int pm, pn, k0, nt, kind, part; };
struct Gemm { const bf16_t* A; const bf16_t* Bt; int ld; };

__device__ __forceinline__ void tile_of(int wgid, int nM, int nN, int& pm, int& pn) {
    const int nwg = nM * nN;
    { const int q = nwg / NXCD, r = nwg % NXCD, xcd = wgid % NXCD, off = wgid / NXCD; wgid = (xcd < r ? xcd * (q + 1) : r * (q + 1) + (xcd - r) * q) + off; }
    const int nig = WGM * nN, gid = wgid / nig, fm = gid * WGM, gsz = (nM - fm) < WGM ? (nM - fm) : WGM;
    pm = fm + ((wgid % nig) % gsz); pn = (wgid % nig) / gsz;
}
struct OrderFull {
    int nM, nN, nwg, G, c, ntk;
    __device__ __forceinline__ void init(int M_, int N_, int K_, int G_, int c_) { nM = M_ / BM; nN = N_ / BM; nwg = nM * nN; G = G_; c = c_; ntk = K_ / BK; }
    __device__ __forceinline__ bool next(int i, Unit& u) const {
        const long L = (long)i * G + c; if (L >= nwg) return false;
        tile_of((int)L, nM, nN, u.pm, u.pn); u.k0 = 0; u.nt = ntk; u.kind = 0; u.part = 0; return true;
    }
    __device__ __forceinline__ void a_ready(const Unit&) const {}
    __device__ __forceinline__ void done(const Unit&) const {}
};
constexpr int NPT_M = 32, NPT_N = 8, NPT = NPT_M * NPT_N, NST = 16;
struct OrderTail {
    int G, c, ntk, nparts, n6;
    __device__ __forceinline__ void init(int K_, int nparts_, int n6_, int G_, int c_) { G = G_; c = c_; ntk = K_ / BK; nparts = nparts_; n6 = n6_; }
    __device__ __forceinline__ bool next(int i, Unit& u) const {
        const int np = c < NPT ? (NPT - c + G - 1) / G : 0;
        const bool isp = i < np;
        const int Lm = (i - np) * G + c;
        if (!isp && Lm >= NST * nparts) return false;
        int pm, pn; tile_of(isp ? i * G + c : 0, NPT_M, NPT_N, pm, pn);
        const int st = Lm % NST, p = Lm / NST;
        const int k6 = 6 * p * BK, k4 = (6 * n6 + 4 * (p - n6)) * BK;
        u.pm = isp ? pm : NPT_M + (st >> 3); u.pn = isp ? pn : (st & 7); u.kind = isp ? 0 : 1; u.part = isp ? 0 : p;
        u.k0 = isp ? 0 : (p < n6 ? k6 : k4); u.nt = isp ? ntk : (p < n6 ? 6 : 4);
        return true;
    }
    __device__ __forceinline__ void a_ready(const Unit&) const {}
    __device__ __forceinline__ void done(const Unit&) const {}
};
struct OrderG3 {
    int G, c;
    __device__ __forceinline__ void init(int G_, int c_) { G = G_; c = c_; }
    __device__ __forceinline__ bool next(int i, Unit& u) const {
        const int np = c < NPT ? (NPT - c + G - 1) / G : 0;
        const bool isp = i < 2 * np;
        const int Lm = (i - 2 * np) * G + c;
        if (!isp && Lm >= NST * 12) return false;
        int pm, pn; tile_of(isp ? (i >> 1) * G + c : 0, NPT_M, NPT_N, pm, pn);
        const int st = Lm % NST, p = Lm / NST, ps = i & 1;
        u.pm = isp ? pm : NPT_M + (st >> 3); u.pn = isp ? pn : (st & 7); u.kind = isp ? ps : 2; u.part = isp ? 0 : p;
        u.k0 = isp ? (ps ? DA : 0) : 4 * p * BK; u.nt = isp ? (ps ? DB / BK : DA / BK) : 4;
        return true;
    }
    __device__ __forceinline__ void a_ready(const Unit&) const {}
    __device__ __forceinline__ void done(const Unit&) const {}
};

__device__ __forceinline__ unsigned cvt_pk_bf16(float lo, float hi) { unsigned r; asm volatile("v_cvt_pk_bf16_f32 %0, %1, %2" : "=v"(r) : "v"(lo), "v"(hi)); return r; }
__device__ __forceinline__ float fsig(float x) { return __builtin_amdgcn_rcpf(1.0f + __builtin_amdgcn_exp2f(-1.4426950408889634f * x)); }
__device__ __forceinline__ float fgelu(float x) { return x * fsig(1.5957691216057308f * x * (1.0f + 0.044715f * x * x)); }
__device__ __forceinline__ float bflo(unsigned w) { return __uint_as_float(w << 16); }
__device__ __forceinline__ float bfhi(unsigned w) { return __uint_as_float(w & 0xffff0000u); }

struct EpiY {
    static constexpr bool PERM = true, AFTER_DRAIN = false, MUT = false, HAS_PRE = false;
    static __device__ __forceinline__ bool keep(const Unit&) { return false; }
    bf16_t* C; bf16_t* P;
    __device__ __forceinline__ void operator()(const f32x4 (&acc)[2][2][4][2], const Unit& u, int wr, int wc, int fr, int fq) const {
        const int col0 = u.pn * BM + wc * 32 + 8 * fq;
        if (u.kind == 0) {
            bf16_t* base = C + (size_t)(u.pm * BM + wr * 64 + fr) * DM + col0;
#pragma unroll
            for (int ai = 0; ai < 2; ++ai)
#pragma unroll
                for (int m = 0; m < 4; ++m) { bf16_t* rowp = base + (size_t)(ai * HALF + m * 16) * DM;
#pragma unroll
                    for (int bj = 0; bj < 2; ++bj) { const f32x4 v0 = acc[ai][bj][m][0], v1 = acc[ai][bj][m][1];
                        u32x4 w; w.x = cvt_pk_bf16(v0[0], v0[1]); w.y = cvt_pk_bf16(v0[2], v0[3]); w.z = cvt_pk_bf16(v1[0], v1[1]); w.w = cvt_pk_bf16(v1[2], v1[3]);
                        *(u32x4*)(rowp + bj * HALF) = w; } }
        } else {
            bf16_t* base = P + (size_t)u.part * MSA * DM + (size_t)((u.pm - NPT_M) * BM + wr * 64 + fr) * DM + col0;
#pragma unroll
            for (int ai = 0; ai < 2; ++ai)
#pragma unroll
                for (int m = 0; m < 4; ++m) { bf16_t* rowp = base + (size_t)(ai * HALF + m * 16) * DM;
#pragma unroll
                    for (int bj = 0; bj < 2; ++bj) { const f32x4 v0 = acc[ai][bj][m][0], v1 = acc[ai][bj][m][1];
                        u32x4 w; w.x = cvt_pk_bf16(v0[0], v0[1]); w.y = cvt_pk_bf16(v0[2], v0[3]); w.z = cvt_pk_bf16(v1[0], v1[1]); w.w = cvt_pk_bf16(v1[2], v1[3]);
                        *(u32x4*)(rowp + bj * HALF) = w; } }
        }
    }
};
struct EpiG1 {
    static constexpr bool PERM = true, AFTER_DRAIN = false, MUT = false, HAS_PRE = true;
    bf16_t* P; u32x4* GF; const float* RS;
    static __device__ __forceinline__ bool keep(const Unit&) { return false; }
    __device__ __forceinline__ void pre(const Unit& u, int wr, int fr, float (&rr)[2][4]) const {
#pragma unroll
        for (int ai = 0; ai < 2; ++ai)
#pragma unroll
            for (int m = 0; m < 4; ++m) rr[ai][m] = RS[u.pm * BM + wr * 64 + fr + ai * HALF + m * 16];
    }
    __device__ __forceinline__ void operator()(const f32x4 (&acc)[2][2][4][2], const Unit& u, int wr, int wc, int fr, int fq, const float (&rr)[2][4]) const {
        const int row0 = u.pm * BM + wr * 64 + fr, pn = u.pn;
        if (pn < 8) {
            const int col0 = C_CX + 128 * pn + wc * 32 + 8 * fq;
#pragma unroll
            for (int ai = 0; ai < 2; ++ai)
#pragma unroll
                for (int m = 0; m < 4; ++m) { bf16_t* rowp = P + (size_t)(row0 + ai * HALF + m * 16) * PP + col0; const float r2 = rr[ai][m] * rr[ai][m];
                    const f32x4 v0 = acc[ai][0][m][0] * acc[ai][1][m][0] * r2, v1 = acc[ai][0][m][1] * acc[ai][1][m][1] * r2;
                    u32x4 w; w.x = cvt_pk_bf16(v0[0], v0[1]); w.y = cvt_pk_bf16(v0[2], v0[3]); w.z = cvt_pk_bf16(v1[0], v1[1]); w.w = cvt_pk_bf16(v1[2], v1[3]);
                    *(u32x4*)rowp = w; }
        } else if (pn >= 28) {
            const int tidx = (wr * 4 + wc) * 64 + fq * 16 + fr;
#pragma unroll
            for (int ai = 0; ai < 2; ++ai)
#pragma unroll
                for (int m = 0; m < 4; ++m) {
                    f32x4 r0, r1, s0, s1; const float rs = -1.4426950408889634f * rr[ai][m];
#pragma unroll
                    for (int j = 0; j < 4; ++j) {
                        const float ea0 = 1.0f + __builtin_amdgcn_exp2f(rs * acc[ai][0][m][0][j]), eb0 = 1.0f + __builtin_amdgcn_exp2f(rs * acc[ai][1][m][0][j]);
                        const float ea1 = 1.0f + __builtin_amdgcn_exp2f(rs * acc[ai][0][m][1][j]), eb1 = 1.0f + __builtin_amdgcn_exp2f(rs * acc[ai][1][m][1][j]);
                        r0[j] = eb0 * __builtin_amdgcn_rcpf(ea0); s0[j] = __builtin_amdgcn_rcpf(eb0); r1[j] = eb1 * __builtin_amdgcn_rcpf(ea1); s1[j] = __builtin_amdgcn_rcpf(eb1); }
                    u32x4 w; w.x = cvt_pk_bf16(r0[0], r0[1]); w.y = cvt_pk_bf16(r0[2], r0[3]); w.z = cvt_pk_bf16(r1[0], r1[1]); w.w = cvt_pk_bf16(r1[2], r1[3]);
                    u32x4* gf = GF + ((size_t)((((u.pm * 16 + (pn - 28)) * 2 + ai) * 4 + m) * 2) * 512 + tidx);
                    gf[0] = w;
                    w.x = cvt_pk_bf16(s0[0], s0[1]); w.y = cvt_pk_bf16(s0[2], s0[3]); w.z = cvt_pk_bf16(s1[0], s1[1]); w.w = cvt_pk_bf16(s1[2], s1[3]);
                    gf[512] = w; }
        } else {
            const int act = pn < 20 ? 0 : 1;
            const int col0 = (pn < 12 ? C_ABG + 256 * (pn - 8) : C_BX + 256 * (pn - 12)) + wc * 32 + 8 * fq;
#pragma unroll
            for (int ai = 0; ai < 2; ++ai)
#pragma unroll
                for (int m = 0; m < 4; ++m) { bf16_t* rowp = P + (size_t)(row0 + ai * HALF + m * 16) * PP + col0;
#pragma unroll
                    for (int bj = 0; bj < 2; ++bj) { f32x4 v0 = acc[ai][bj][m][0] * rr[ai][m], v1 = acc[ai][bj][m][1] * rr[ai][m];
                        if (act == 1) {
#pragma unroll
                            for (int j = 0; j < 4; ++j) { v0[j] = fgelu(v0[j]); v1[j] = fgelu(v1[j]); } }
                        u32x4 w; w.x = cvt_pk_bf16(v0[0], v0[1]); w.y = cvt_pk_bf16(v0[2], v0[3]); w.z = cvt_pk_bf16(v1[0], v1[1]); w.w = cvt_pk_bf16(v1[2], v1[3]);
                        *(u32x4*)(rowp + bj * HALF) = w; } }
        }
    }
};
struct EpiG3 {
    static constexpr bool PERM = true, AFTER_DRAIN = false, MUT = true, HAS_PRE = false;
    const u32x4* GF; bf16_t* MRG; bf16_t* SL;
    static __device__ __forceinline__ bool keep(const Unit& u) { return u.kind == 0; }
    __device__ __forceinline__ void operator()(f32x4 (&acc)[2][2][4][2], const Unit& u, int wr, int wc, int fr, int fq) const {
        const int row0 = u.pm * BM + wr * 64 + fr, col0 = u.pn * BM + wc * 32 + 8 * fq;
        const bool needr = (u.kind == 0) || (u.kind == 2 && u.part < 4), needs = u.kind != 0;
        bf16_t* sbase = SL + (size_t)u.part * MSA * DM - (size_t)MPR * DM;
        const int tidx = (wr * 4 + wc) * 64 + fq * 16 + fr;
#pragma unroll
        for (int ai = 0; ai < 2; ++ai)
#pragma unroll
            for (int mh = 0; mh < 2; ++mh) {
                u32x4 gr[2][2], gs[2][2];
#pragma unroll
                for (int mm = 0; mm < 2; ++mm)
#pragma unroll
                    for (int bj = 0; bj < 2; ++bj) { const size_t row = (size_t)(row0 + ai * HALF + (2 * mh + mm) * 16);
                        gr[mm][bj] = (u32x4){0x3f803f80u, 0x3f803f80u, 0x3f803f80u, 0x3f803f80u}; gs[mm][bj] = gr[mm][bj];
                        const u32x4* gf = GF + ((size_t)((((u.pm * 16 + 2 * u.pn + bj) * 2 + ai) * 4 + (2 * mh + mm)) * 2) * 512 + tidx); (void)row;
                        if (needr) gr[mm][bj] = gf[0];
                        if (needs) gs[mm][bj] = gf[512]; }
#pragma unroll
                for (int mm = 0; mm < 2; ++mm)
#pragma unroll
                    for (int bj = 0; bj < 2; ++bj) { const int m = 2 * mh + mm; const size_t row = (size_t)(row0 + ai * HALF + m * 16);
                        const u32x4 a = gr[mm][bj], b = gs[mm][bj];
                        const f32x4 g0 = (f32x4){bflo(a.x), bfhi(a.x), bflo(a.y), bfhi(a.y)} * (f32x4){bflo(b.x), bfhi(b.x), bflo(b.y), bfhi(b.y)};
                        const f32x4 g1 = (f32x4){bflo(a.z), bfhi(a.z), bflo(a.w), bfhi(a.w)} * (f32x4){bflo(b.z), bfhi(b.z), bflo(b.w), bfhi(b.w)};
                        const f32x4 v0 = acc[ai][bj][m][0] * g0, v1 = acc[ai][bj][m][1] * g1;
                        if (u.kind == 0) { acc[ai][bj][m][0] = v0; acc[ai][bj][m][1] = v1; }
                        else if (u.kind == 1) { u32x4 w; w.x = cvt_pk_bf16(v0[0], v0[1]); w.y = cvt_pk_bf16(v0[2], v0[3]); w.z = cvt_pk_bf16(v1[0], v1[1]); w.w = cvt_pk_bf16(v1[2], v1[3]);
                            *(u32x4*)(MRG + row * DM + col0 + bj * HALF) = w; }
                        else { u32x4 w; w.x = cvt_pk_bf16(v0[0], v0[1]); w.y = cvt_pk_bf16(v0[2], v0[3]); w.z = cvt_pk_bf16(v1[0], v1[1]); w.w = cvt_pk_bf16(v1[2], v1[3]);
                            *(u32x4*)(sbase + row * DM + col0 + bj * HALF) = w; } }
            }
    }
};
struct EpiG5 {
    static constexpr bool PERM = true, AFTER_DRAIN = false, MUT = false, HAS_PRE = true;
    static __device__ __forceinline__ bool keep(const Unit&) { return false; }
    bf16_t* H; const float* RS;
    __device__ __forceinline__ void pre(const Unit& u, int wr, int fr, float (&rr)[2][4]) const {
#pragma unroll
        for (int ai = 0; ai < 2; ++ai)
#pragma unroll
            for (int m = 0; m < 4; ++m) rr[ai][m] = RS[u.pm * BM + wr * 64 + fr + ai * HALF + m * 16];
    }
    __device__ __forceinline__ void operator()(const f32x4 (&acc)[2][2][4][2], const Unit& u, int wr, int wc, int fr, int fq, const float (&rr)[2][4]) const {
        const int row0 = u.pm * BM + wr * 64 + fr, col0 = 128 * u.pn + wc * 32 + 8 * fq;
#pragma unroll
        for (int ai = 0; ai < 2; ++ai)
#pragma unroll
            for (int m = 0; m < 4; ++m) { bf16_t* rowp = H + (size_t)(row0 + ai * HALF + m * 16) * FF + col0;
                f32x4 v0, v1;
#pragma unroll
                for (int j = 0; j < 4; ++j) { const float r = rr[ai][m], a = acc[ai][0][m][0][j] * r, b = acc[ai][0][m][1][j] * r; v0[j] = a * fsig(a) * (acc[ai][1][m][0][j] * r); v1[j] = b * fsig(b) * (acc[ai][1][m][1][j] * r); }
                u32x4 w; w.x = cvt_pk_bf16(v0[0], v0[1]); w.y = cvt_pk_bf16(v0[2], v0[3]); w.z = cvt_pk_bf16(v1[0], v1[1]); w.w = cvt_pk_bf16(v1[2], v1[3]);
                *(u32x4*)rowp = w; }
    }
};

template <class Epi, class Sched, bool ALIGN_EPI = false, bool SP2 = false>
__device__ __forceinline__ void gemm_phase(PG8_LAS unsigned char* lds, const Gemm g, const Sched& S, const Epi& E) {
    int tid_ = threadIdx.x; asm volatile("" : "+v"(tid_));
    const int tid = tid_, wid = __builtin_amdgcn_readfirstlane(tid >> 6), lane = tid & 63, wr = wid >> 2, wc = wid & 3, fr = lane & 15, fq = lane >> 4;
    const int K = g.ld;
    unsigned voffA[2], voffB[2];
#pragma unroll
    for (int i = 0; i < 2; ++i) { int R, C; stage_rc(tid * 16 + i * 8192, R, C); const int Rb = Epi::PERM ? ((R & ~31) + perm32(R & 31)) : R;
        voffA[i] = (unsigned)(R * K + C) * 2u; voffB[i] = (unsigned)(Rb * K + C) * 2u; }
    const size_t kstep = (size_t)(BK * 2);
    const size_t hstep = (size_t)HALF * K * 2;
    const size_t tstep = 2 * hstep;
    const unsigned ldsw = (unsigned)wid * 1024u;
    const int aoff = lds_byte(wr * 64 + fr, fq * 8), boff = lds_byte(wc * 32 + fr, fq * 8);
#define PG8_SA(b, h) (((b) * 2 + (h)) * HTB)
#define PG8_SB(b, h) ((4 + (b) * 2 + (h)) * HTB)
#define PG8_STAGE(bufoff, gbase, voff) do { _Pragma("unroll") for (int _i = 0; _i < 2; ++_i) \
        __builtin_amdgcn_global_load_lds((const unsigned*)((const char*)(gbase) + (voff)[_i]), (PG8_LAS unsigned*)(lds + (bufoff) + ldsw + _i * 8192), 16, 0, 0); } while (0)
#define PG8_LDA(dst, b, h) do { _Pragma("unroll") for (int m = 0; m < 4; ++m) _Pragma("unroll") for (int k = 0; k < 2; ++k) dst[m][k] = *(const PG8_LAS bf16x8*)(lds + PG8_SA(b, h) + aoff + m * 2048 + k * 1024); } while (0)
#define PG8_LDB(dst, b, h) do { _Pragma("unroll") for (int n = 0; n < 2; ++n) _Pragma("unroll") for (int k = 0; k < 2; ++k) dst[n][k] = *(const PG8_LAS bf16x8*)(lds + PG8_SB(b, h) + boff + n * 2048 + k * 1024); } while (0)
#define PG8_MMA(ai, bj, At, Bt) do { __builtin_amdgcn_s_setprio(1); _Pragma("unroll") for (int m = 0; m < 4; ++m) _Pragma("unroll") for (int n = 0; n < 2; ++n) _Pragma("unroll") for (int k = 0; k < 2; ++k) \
        acc[ai][bj][m][n] = __builtin_amdgcn_mfma_f32_16x16x32_bf16(Bt[n][k], At[m][k], acc[ai][bj][m][n], 0, 0, 0); __builtin_amdgcn_s_setprio(0); } while (0)
#define PG8_WAIT_V(n) asm volatile("s_waitcnt vmcnt(" #n ")" ::: "memory")
#define PG8_WAIT_L(n) asm volatile("s_waitcnt lgkmcnt(" #n ")" ::: "memory")
#define PG8_BAR __builtin_amdgcn_s_barrier()
#define PG8_SCHED __builtin_amdgcn_sched_barrier(0)
    Unit cur, nxt; int ui = 0;
    if (!S.next(0, cur)) return;
    f32x4 acc[2][2][4][2];
#pragma unroll
    for (int a = 0; a < 2; ++a)
#pragma unroll
        for (int b = 0; b < 2; ++b)
#pragma unroll
            for (int m = 0; m < 4; ++m)
#pragma unroll
                for (int n = 0; n < 2; ++n) acc[a][b][m][n] = (f32x4){0.f, 0.f, 0.f, 0.f};
    bf16x8 At[4][2], B0[2][2], B1[2][2];
    const char* cA = (const char*)g.A + (size_t)cur.pm * tstep + (size_t)cur.k0 * 2; const char* cB = (const char*)g.Bt + (size_t)cur.pn * tstep + (size_t)cur.k0 * 2;
    S.a_ready(cur);
    float pre[2][4];
    if constexpr (Epi::HAS_PRE) E.pre(cur, wr, fr, pre);
    if constexpr (SP2) {
        PG8_STAGE(PG8_SB(0, 0), cB, voffB); PG8_STAGE(PG8_SB(0, 1), cB + hstep, voffB); PG8_STAGE(PG8_SA(0, 0), cA, voffA); PG8_STAGE(PG8_SA(0, 1), cA + hstep, voffA);
        if (wr == 1) PG8_BAR;
        PG8_WAIT_V(2); PG8_BAR;
        PG8_STAGE(PG8_SB(1, 0), cB + kstep, voffB); PG8_STAGE(PG8_SA(1, 0), cA + kstep, voffA); PG8_STAGE(PG8_SB(1, 1), cB + hstep + kstep, voffB);
        PG8_WAIT_V(6); PG8_BAR;
    } else {
        PG8_STAGE(PG8_SB(0, 0), cB, voffB); PG8_STAGE(PG8_SA(0, 0), cA, voffA); PG8_STAGE(PG8_SB(0, 1), cB + hstep, voffB); PG8_STAGE(PG8_SA(0, 1), cA + hstep, voffA);
        if (wr == 1) PG8_BAR;
        PG8_WAIT_V(4); PG8_BAR;
        PG8_STAGE(PG8_SB(1, 0), cB + kstep, voffB); PG8_STAGE(PG8_SA(1, 0), cA + kstep, voffA); PG8_STAGE(PG8_SB(1, 1), cB + hstep + kstep, voffB);
        PG8_WAIT_V(6); PG8_BAR;
    }
    for (;;) {
        const bool has_next = S.next(ui + 1, nxt);
        const char* nA = has_next ? (const char*)g.A + (size_t)nxt.pm * tstep + (size_t)nxt.k0 * 2 : cA; const char* nB = has_next ? (const char*)g.Bt + (size_t)nxt.pn * tstep + (size_t)nxt.k0 * 2 : cB;
        const int nt = cur.nt;
        for (int t = 0; t < nt; t += 2) {
            const bool last = (t == nt - 2);
            const char* a1 = cA + (size_t)(t + 1) * kstep;
            const char* a2 = last ? nA : cA + (size_t)(t + 2) * kstep; const char* b2 = last ? nB : cB + (size_t)(t + 2) * kstep;
            const char* a3 = a2 + kstep; const char* b3 = b2 + kstep;
            if (last && has_next) S.a_ready(nxt);
            if constexpr (SP2) {
            PG8_LDB(B0, 0, 0); PG8_LDB(B1, 0, 1); PG8_SCHED; PG8_LDA(At, 0, 0); PG8_STAGE(PG8_SA(1, 1), a1 + hstep, voffA);
            PG8_WAIT_V(8); PG8_WAIT_L(0); PG8_BAR; PG8_MMA(0, 0, At, B0); PG8_MMA(0, 1, At, B1); PG8_BAR; PG8_SCHED;
            PG8_LDA(At, 0, 1); PG8_STAGE(PG8_SB(0, 0), b2, voffB); PG8_STAGE(PG8_SB(0, 1), b2 + hstep, voffB); PG8_STAGE(PG8_SA(0, 0), a2, voffA);
            PG8_WAIT_V(8); PG8_WAIT_L(0); PG8_BAR; PG8_MMA(1, 0, At, B0); PG8_MMA(1, 1, At, B1); PG8_BAR; PG8_SCHED;
            PG8_LDB(B0, 1, 0); PG8_LDB(B1, 1, 1); PG8_SCHED; PG8_LDA(At, 1, 0); PG8_STAGE(PG8_SA(0, 1), a2 + hstep, voffA);
            PG8_WAIT_V(8); PG8_WAIT_L(0); PG8_BAR; PG8_MMA(0, 0, At, B0); PG8_MMA(0, 1, At, B1); PG8_BAR; PG8_SCHED;
            PG8_LDA(At, 1, 1); PG8_STAGE(PG8_SB(1, 0), b3, voffB); PG8_STAGE(PG8_SB(1, 1), b3 + hstep, voffB); PG8_STAGE(PG8_SA(1, 0), a3, voffA);
            PG8_WAIT_V(8); PG8_WAIT_L(0); PG8_BAR; PG8_MMA(1, 0, At, B0); PG8_MMA(1, 1, At, B1); PG8_BAR; PG8_SCHED;
            } else {
            PG8_LDB(B0, 0, 0); PG8_SCHED; PG8_LDA(At, 0, 0); PG8_STAGE(PG8_SA(1, 1), a1 + hstep, voffA);
            PG8_WAIT_L(8); PG8_BAR; PG8_WAIT_L(0); PG8_MMA(0, 0, At, B0); PG8_BAR; PG8_SCHED;
            PG8_LDB(B1, 0, 1); PG8_STAGE(PG8_SB(0, 0), b2, voffB);
            PG8_BAR; PG8_WAIT_L(0); PG8_MMA(0, 1, At, B1); PG8_BAR;
            PG8_LDA(At, 0, 1); PG8_STAGE(PG8_SA(0, 0), a2, voffA);
            PG8_BAR; PG8_WAIT_L(0); PG8_MMA(1, 0, At, B0); PG8_BAR; PG8_SCHED;
            PG8_STAGE(PG8_SB(0, 1), b2 + hstep, voffB);
            PG8_WAIT_V(6); PG8_BAR; PG8_MMA(1, 1, At, B1); PG8_BAR;
            PG8_LDB(B0, 1, 0); PG8_SCHED; PG8_LDA(At, 1, 0); PG8_STAGE(PG8_SA(0, 1), a2 + hstep, voffA);
            PG8_WAIT_L(8); PG8_BAR; PG8_WAIT_L(0); PG8_MMA(0, 0, At, B0); PG8_BAR; PG8_SCHED;
            PG8_LDB(B1, 1, 1); PG8_STAGE(PG8_SB(1, 0), b3, voffB);
            PG8_BAR; PG8_WAIT_L(0); PG8_MMA(0, 1, At, B1); PG8_BAR;
            PG8_LDA(At, 1, 1); PG8_STAGE(PG8_SA(1, 0), a3, voffA);
            PG8_BAR; PG8_WAIT_L(0); PG8_MMA(1, 0, At, B0); PG8_BAR; PG8_SCHED;
            PG8_STAGE(PG8_SB(1, 1), b3 + hstep, voffB);
            PG8_WAIT_V(6); PG8_BAR; PG8_MMA(1, 1, At, B1); PG8_BAR;
            }
        }
        if constexpr (ALIGN_EPI) { if (wr == 0) PG8_BAR; }
        if constexpr (Epi::HAS_PRE) { E(acc, cur, wr, wc, fr, fq, pre); } else { E(acc, cur, wr, wc, fr, fq); }
        if (!has_next) break;
        if (!Epi::keep(cur)) {
#pragma unroll
        for (int a = 0; a < 2; ++a)
#pragma unroll
            for (int b = 0; b < 2; ++b)
#pragma unroll
                for (int m = 0; m < 4; ++m)
#pragma unroll
                    for (int n = 0; n < 2; ++n) acc[a][b][m][n] = (f32x4){0.f, 0.f, 0.f, 0.f};
        }
        cur = nxt; cA = nA; cB = nB; ++ui;
        if constexpr (Epi::HAS_PRE) E.pre(cur, wr, fr, pre);
        if constexpr (ALIGN_EPI) { if (wr == 1) PG8_BAR; }
    }
    PG8_WAIT_V(0);
    if constexpr (!ALIGN_EPI) { if (wr == 0) PG8_BAR; }
    PG8_BAR;
#undef PG8_SA
#undef PG8_SB
#undef PG8_STAGE
#undef PG8_LDA
#undef PG8_LDB
#undef PG8_MMA
#undef PG8_WAIT_V
#undef PG8_WAIT_L
#undef PG8_BAR
#undef PG8_SCHED
}
}

constexpr int NWAVES = 8;
constexpr int RING_OFF = 0, RING_BYTES = 131072;
constexpr int LDSCTL_OFF = RING_BYTES, MISC_OFF = LDSCTL_OFF + 320;
constexpr int LDS_BYTES = 147456;
constexpr int SC_XH = 0;
constexpr int SC_XF = 20480;
constexpr int SC_HT = 53248;
constexpr int SC_CT = 73728;
constexpr int SC_CW = 94208;
constexpr int XHP = 136;
static_assert(SC_XH + 64 * XHP * 2 <= SC_XF && SC_XF + 32768 <= SC_HT && SC_HT + 64 * XHP * 2 <= SC_CT && SC_CT + 64 * XHP * 2 <= SC_CW && SC_CW + 2560 <= RING_BYTES, "scan LDS map");

#define GAS __attribute__((address_space(1)))
#define LAS __attribute__((address_space(3)))
typedef unsigned short bf16;
typedef unsigned v4u __attribute__((ext_vector_type(4)));
typedef unsigned v2u __attribute__((ext_vector_type(2)));
typedef float f32x4 __attribute__((ext_vector_type(4)));
typedef float f32x2 __attribute__((ext_vector_type(2)));
typedef short bf16x8 __attribute__((ext_vector_type(8)));
typedef GAS unsigned gu32;
#define RLX_AGENT __ATOMIC_RELAXED, __HIP_MEMORY_SCOPE_AGENT
#define LDS_WAIT() asm volatile("s_waitcnt lgkmcnt(0)" ::: "memory")
#define VM_WAIT() asm volatile("s_waitcnt vmcnt(0)" ::: "memory")
__device__ __forceinline__ unsigned f2bf(float f) { unsigned u = __builtin_bit_cast(unsigned, f); return (u + 0x7fffu + ((u >> 16) & 1u)) >> 16; }
__device__ __forceinline__ unsigned pk2(float lo, float hi) { return f2bf(lo) | (f2bf(hi) << 16); }
__device__ __forceinline__ float bf2f(unsigned short b) { return __uint_as_float(((unsigned)b) << 16); }

#define XB_TMO      128
#define XB_XCNT(j)  (256  + 64 * (j))
#define XB_XSUB(j)  (1280 + 64 * (j))
#define XB_XGEN(j)  (2304 + 64 * (j))
#define XB_TOP      3328
#define XB_TOPGEN   3392
#define XCD_BAR_WORDS 3456
#define XB_SPIN_CAP (1u << 18)

__device__ __forceinline__ unsigned xb_ld(unsigned* p)              { return __hip_atomic_load(p, __ATOMIC_RELAXED, __HIP_MEMORY_SCOPE_AGENT); }
__device__ __forceinline__ unsigned xb_add(unsigned* p, unsigned v) { return __hip_atomic_fetch_add(p, v, __ATOMIC_RELAXED, __HIP_MEMORY_SCOPE_AGENT); }
__device__ __forceinline__ unsigned xb_xcc_id() { return (unsigned)__builtin_amdgcn_s_getreg((3 << 11) | 20) & 0xFu; }
#define XB_SPIN(cond, bar) do { unsigned _sp = 0; while (cond) { __builtin_amdgcn_s_sleep(1); \
    if ((++_sp & 255u) == 0u) { if (xb_ld(&(bar)[XB_TMO])) break; if (_sp > XB_SPIN_CAP) { atomicAdd(&(bar)[XB_TMO], 1u); break; } } } } while (0)

struct XcdBarrier {
    unsigned* bar; unsigned x;
    volatile LAS unsigned* st;
};
__device__ __forceinline__ XcdBarrier xcd_barrier_post(unsigned* bar, volatile LAS unsigned* st) {
    XcdBarrier b; b.bar = bar; b.x = xb_xcc_id(); b.st = st;
    if (threadIdx.x == 0) (void)xb_add(&bar[XB_XCNT(b.x)], 1u);
    return b;
}
__device__ __forceinline__ void xcd_barrier_complete(unsigned* bar, unsigned x, unsigned& nloc, unsigned& nx) {
    const unsigned G = gridDim.x * gridDim.y * gridDim.z;
    unsigned sum, cnt, mine, sp = 0u;
    for (;;) {
        sum = 0u; cnt = 0u; mine = 0u;
#pragma unroll
        for (unsigned j = 0; j < 16; ++j) { const unsigned c = xb_ld(&bar[XB_XCNT(j)]); sum += c; cnt += (c > 0u) ? 1u : 0u; mine = (j == x) ? c : mine; }
        if (sum == G) break;
        __builtin_amdgcn_s_sleep(1);
        if ((++sp & 255u) == 0u) { if (xb_ld(&bar[XB_TMO])) break; if (sp > XB_SPIN_CAP) { atomicAdd(&bar[XB_TMO], 1u); break; } }
    }
    nloc = mine > 0u ? mine : 1u; nx = cnt > 0u ? cnt : 1u;
}
__device__ __forceinline__ void xcd_barrier(const XcdBarrier& b) {
    asm volatile("s_waitcnt vmcnt(0)" ::: "memory");
    __syncthreads();
    if (threadIdx.x == 0) {
        unsigned* bar = b.bar;
        __builtin_amdgcn_s_waitcnt(0);
        unsigned nloc = b.st[0], nx = b.st[1];
        if (nloc == 0u) { xcd_barrier_complete(bar, b.x, nloc, nx); b.st[0] = nloc; b.st[1] = nx; }
        const unsigned old = xb_add(&bar[XB_XSUB(b.x)], 1u);
        const unsigned gen = old / nloc;
        if (old + 1u == (gen + 1u) * nloc) {
            __builtin_amdgcn_fence(__ATOMIC_RELEASE, "agent");
            asm volatile("s_waitcnt vmcnt(0)" ::: "memory");
            const unsigned og = xb_add(&bar[XB_TOP], 1u);
            const unsigned tg = og / nx;
            if (og + 1u == (tg + 1u) * nx) xb_add(&bar[XB_TOPGEN], 1u);
            else XB_SPIN(xb_ld(&bar[XB_TOPGEN]) == tg, bar);
            __builtin_amdgcn_fence(__ATOMIC_ACQUIRE, "agent");
            xb_add(&bar[XB_XGEN(b.x)], 1u);
            asm volatile("s_waitcnt vmcnt(0)" ::: "memory");
        } else {
            XB_SPIN(xb_ld(&bar[XB_XGEN(b.x)]) == gen, bar);
            __builtin_amdgcn_fence(__ATOMIC_ACQUIRE, "agent");
            asm volatile("s_waitcnt vmcnt(0)" ::: "memory");
        }
    }
    __syncthreads();
}

constexpr int CW_BAR = 4096;
constexpr int PPL = 10;
struct Args { const float* in[23]; float* out; unsigned char* ws; int ph_lo, ph_hi; };
typedef const Args __attribute__((address_space(4)))* KArgs;
__device__ __forceinline__ KArgs kargs() { KArgs p = (KArgs)__builtin_amdgcn_kernarg_segment_ptr(); asm volatile("" : "+s"(p)); return p; }
enum { I_XP = 0, I_XS, I_SCA, I_SCB, I_SH, I_WIN, I_CAW, I_WOA, I_CBW, I_CBB, I_WR, I_BR, I_WI, I_BI, I_LAM, I_WOB, I_WO, I_NPM, I_NQM, I_NPF, I_NQF, I_WGU, I_WDN };

__device__ __forceinline__ float wave_sum(float v) {
#pragma unroll
    for (int o = 1; o < 64; o <<= 1) v += __shfl_xor(v, o);
    return v;
}

struct TrDesc { const float* W; const float* gk; bf16* WT; int Np, k0, n0, ldk, drow, dk; };
__device__ __forceinline__ void tr_load(const TrDesc& d, f32x4 (&va)[8], f32x4 (&vb)[8], f32x2 (&gg)[8], int lane) {
    const int lc = lane & 15, lr = lane >> 4;
#pragma unroll
    for (int i = 0; i < 8; ++i) { const int kk = 2 * (lr + 4 * i); const float* p = d.W + (size_t)(d.k0 + kk) * d.Np + d.n0 + 4 * lc;
        va[i] = *(const GAS f32x4*)p; vb[i] = *(const GAS f32x4*)(p + d.Np); }
#pragma unroll
    for (int i = 0; i < 8; ++i) { gg[i] = (f32x2){1.f, 1.f}; if (d.gk) gg[i] = *(const GAS f32x2*)(d.gk + d.k0 + 2 * (lr + 4 * i)); }
}
__device__ __forceinline__ void tr_store(const TrDesc& d, f32x4 (&va)[8], f32x4 (&vb)[8], const f32x2 (&gg)[8], LAS unsigned* T, int lane) {
    const int lc = lane & 15, lr = lane >> 4;
#pragma unroll
    for (int i = 0; i < 8; ++i) { va[i] = va[i] * gg[i].x; vb[i] = vb[i] * gg[i].y; }
#pragma unroll
    for (int i = 0; i < 8; ++i) { LAS unsigned* t = T + (lr + 4 * i) * 66 + 4 * lc;
        v2u a; a.x = pk2(va[i][0], vb[i][0]); a.y = pk2(va[i][1], vb[i][1]); v2u b; b.x = pk2(va[i][2], vb[i][2]); b.y = pk2(va[i][3], vb[i][3]);
        *(LAS v2u*)t = a; *(LAS v2u*)(t + 2) = b; }
    LDS_WAIT(); asm volatile("" ::: "memory");
    const int c = lane & 7;
#pragma unroll
    for (int j = 0; j < 8; ++j) { const int nn = (lane >> 3) + 8 * j; const LAS unsigned* sp = T + (4 * c) * 66 + nn;
        v4u o; o.x = sp[0]; o.y = sp[66]; o.z = sp[132]; o.w = sp[198];
        *(GAS v4u*)(d.WT + (size_t)(d.drow + nn) * d.ldk + d.dk + d.k0 + 8 * c) = o; }
    LDS_WAIT(); asm volatile("" ::: "memory");
}
__device__ __forceinline__ int map_in(int n) {
    if (n < 1024) return 2048 + n;
    if (n < 2048) { const int q = n - 1024; return 256 * (q >> 7) + (q & 127); }
    if (n < 3072) { const int q = n - 2048; return 256 * (q >> 7) + 128 + (q & 127); }
    if (n < 7168) return n;
    if (n < 9216) { const int q = n - 7168; return 7168 + 256 * (q >> 7) + (q & 127); }
    { const int q = n - 9216; return 7168 + 256 * (q >> 7) + 128 + (q & 127); }
}
__device__ __forceinline__ int map_gu(int n) {
    if (n < FF) return 256 * (n >> 7) + (n & 127);
    const int q = n - FF; return 256 * (q >> 7) + 128 + (q & 127);
}
constexpr int IT_IN = (DM / 64) * (NIN / 64), IT_OA = (DA / 64) * (DM / 64), IT_OB = (DB / 64) * (DM / 64), IT_O = (DM / 64) * (DM / 64), IT_GU = IT_IN, IT_DN = (FF / 64) * (DM / 64), IT_R = 16 * 4;
constexpr int IT_LAYER = IT_IN + IT_OA + IT_OB + IT_O + IT_GU + IT_DN + 2 * IT_R;

__device__ __forceinline__ TrDesc conv_desc(KArgs args, unsigned char* ws, int it) {
    const int l = it / IT_LAYER; int r = it - l * IT_LAYER;
    unsigned char* wl = ws + WS_W + (size_t)l * WL_STRIDE;
    TrDesc d; d.gk = nullptr; d.dk = 0; int kb, nb;
    if (r < IT_IN) { kb = r / (NIN / 64); nb = r % (NIN / 64); d.W = args->in[I_WIN] + (size_t)l * DM * NIN; d.Np = NIN; d.WT = (bf16*)(wl + WL_IN); d.ldk = DM; d.drow = map_in(64 * nb); d.gk = args->in[I_NPM] + (size_t)l * DM; }
    else if ((r -= IT_IN) < IT_OA) { kb = r / (DM / 64); nb = r % (DM / 64); d.W = args->in[I_WOA] + (size_t)l * DA * DM; d.Np = DM; d.WT = (bf16*)(wl + WL_AB); d.ldk = ZP; d.drow = 64 * nb; }
    else if ((r -= IT_OA) < IT_OB) { kb = r / (DM / 64); nb = r % (DM / 64); d.W = args->in[I_WOB] + (size_t)l * DB * DM; d.Np = DM; d.WT = (bf16*)(wl + WL_AB); d.ldk = ZP; d.drow = 64 * nb; d.dk = DA; }
    else if ((r -= IT_OB) < IT_O) { kb = r / (DM / 64); nb = r % (DM / 64); d.W = args->in[I_WO] + (size_t)l * DM * DM; d.Np = DM; d.WT = (bf16*)(wl + WL_O); d.ldk = DM; d.drow = 64 * nb; }
    else if ((r -= IT_O) < IT_GU) { kb = r / (NIN / 64); nb = r % (NIN / 64); d.W = args->in[I_WGU] + (size_t)l * DM * NIN; d.Np = NIN; d.WT = (bf16*)(wl + WL_GU); d.ldk = DM; d.drow = map_gu(64 * nb); d.gk = args->in[I_NPF] + (size_t)l * DM; }
    else if ((r -= IT_GU) < IT_DN) { kb = r / (DM / 64); nb = r % (DM / 64); d.W = args->in[I_WDN] + (size_t)l * FF * DM; d.Np = DM; d.WT = (bf16*)(wl + WL_DN); d.ldk = FF; d.drow = 64 * nb; }
    else { r -= IT_DN; const int isI = r >= IT_R; if (isI) r -= IT_R; const int hh = r >> 2; kb = (r >> 1) & 1; nb = r & 1;
        d.W = args->in[isI ? I_WI : I_WR] + (size_t)(l * 16 + hh) * 128 * 128; d.Np = 128; d.WT = (bf16*)(wl + WL_RI); d.ldk = 128; d.drow = hh * 256 + (isI ? 128 : 0) + 64 * nb; }
    d.k0 = 64 * kb; d.n0 = 64 * nb;
    return d;
}

__device__ __forceinline__ void thin_row(const bf16* yrow, const float* xin, bf16* xb, float* outf, float* rs, const float* g1, int lane) {
    f32x4 x[8];
    if (yrow) {
        f32x4 y[8]; float s = 0.f;
#pragma unroll
        for (int j = 0; j < 8; ++j) { const v2u w = ((const GAS v2u*)yrow)[lane + 64 * j]; y[j] = (f32x4){pg8::bflo(w.x), pg8::bfhi(w.x), pg8::bflo(w.y), pg8::bfhi(w.y)}; }
#pragma unroll
        for (int j = 0; j < 8; ++j) { const v2u w = ((const GAS v2u*)xb)[lane + 64 * j]; x[j] = (f32x4){pg8::bflo(w.x), pg8::bfhi(w.x), pg8::bflo(w.y), pg8::bfhi(w.y)}; }
#pragma unroll
        for (int j = 0; j < 8; ++j) s += (y[j].x * y[j].x + y[j].y * y[j].y) + (y[j].z * y[j].z + y[j].w * y[j].w);
        const float r1 = 1.0f / sqrtf(wave_sum(s) * (1.0f / DM) + EPS);
#pragma unroll
        for (int j = 0; j < 8; ++j) { const f32x4 g = ((const GAS f32x4*)g1)[lane + 64 * j]; x[j] += y[j] * r1 * g; }
    } else {
#pragma unroll
        for (int j = 0; j < 8; ++j) x[j] = ((const GAS f32x4*)xin)[lane + 64 * j];
    }
    if (outf) {
#pragma unroll
        for (int j = 0; j < 8; ++j) ((GAS f32x4*)outf)[lane + 64 * j] = x[j];
    } else {
        float s = 0.f;
#pragma unroll
        for (int j = 0; j < 8; ++j) { s += (x[j].x * x[j].x + x[j].y * x[j].y) + (x[j].z * x[j].z + x[j].w * x[j].w);
            v2u w; w.x = pk2(x[j].x, x[j].y); w.y = pk2(x[j].z, x[j].w); ((GAS v2u*)xb)[lane + 64 * j] = w; }
        const float r2 = 1.0f / sqrtf(wave_sum(s) * (1.0f / DM) + EPS);
        if (lane == 0) *rs = r2;
    }
}
__device__ __forceinline__ void convert_items(KArgs args, unsigned char* ws, LAS unsigned* T, int lo, int hi, int gw, int NGW, int lane) {
    f32x4 a0[8], b0[8], a1[8], b1[8]; f32x2 g0[8], g1[8]; TrDesc d0 = {}, d1 = {};
    int it = lo + gw;
    if (it < hi) { d0 = conv_desc(args, ws, it); tr_load(d0, a0, b0, g0, lane); }
    while (it < hi) {
        int nx = it + NGW;
        if (nx < hi) { d1 = conv_desc(args, ws, nx); tr_load(d1, a1, b1, g1, lane); }
        tr_store(d0, a0, b0, g0, T, lane);
        it = nx; if (it >= hi) break;
        nx = it + NGW;
        if (nx < hi) { d0 = conv_desc(args, ws, nx); tr_load(d0, a0, b0, g0, lane); }
        tr_store(d1, a1, b1, g1, T, lane);
        it = nx;
    }
}
struct ThinIn { v2u y[8], x[8]; };
__device__ __forceinline__ void thin_load(ThinIn& I, const bf16* yrow, const bf16* xb, int lane) {
#pragma unroll
    for (int j = 0; j < 8; ++j) I.y[j] = ((const GAS v2u*)yrow)[lane + 64 * j];
#pragma unroll
    for (int j = 0; j < 8; ++j) I.x[j] = ((const GAS v2u*)xb)[lane + 64 * j];
}
__device__ __forceinline__ void thin_fin(const ThinIn& I, const f32x4 (&g)[8], bf16* xb, float* outf, float* rs, int lane) {
    f32x4 x[8], y[8]; float s = 0.f;
#pragma unroll
    for (int j = 0; j < 8; ++j) { y[j] = (f32x4){pg8::bflo(I.y[j].x), pg8::bfhi(I.y[j].x), pg8::bflo(I.y[j].y), pg8::bfhi(I.y[j].y)};
        x[j] = (f32x4){pg8::bflo(I.x[j].x), pg8::bfhi(I.x[j].x), pg8::bflo(I.x[j].y), pg8::bfhi(I.x[j].y)}; }
#pragma unroll
    for (int j = 0; j < 8; ++j) s += (y[j].x * y[j].x + y[j].y * y[j].y) + (y[j].z * y[j].z + y[j].w * y[j].w);
    const float r1 = 1.0f / sqrtf(wave_sum(s) * (1.0f / DM) + EPS);
#pragma unroll
    for (int j = 0; j < 8; ++j) x[j] += y[j] * r1 * g[j];
    if (outf) {
#pragma unroll
        for (int j = 0; j < 8; ++j) ((GAS f32x4*)outf)[lane + 64 * j] = x[j];
    } else {
        float s2 = 0.f;
#pragma unroll
        for (int j = 0; j < 8; ++j) { s2 += (x[j].x * x[j].x + x[j].y * x[j].y) + (x[j].z * x[j].z + x[j].w * x[j].w);
            v2u w; w.x = pk2(x[j].x, x[j].y); w.y = pk2(x[j].z, x[j].w); ((GAS v2u*)xb)[lane + 64 * j] = w; }
        const float r2 = 1.0f / sqrtf(wave_sum(s2) * (1.0f / DM) + EPS);
        if (lane == 0) *rs = r2;
    }
}
__device__ __forceinline__ void thin_rows(const bf16* Y, bf16* XB, float* X, float* RS, const float* g1, int gw, int NGW, int lane) {
    f32x4 g[8];
#pragma unroll
    for (int j = 0; j < 8; ++j) g[j] = ((const GAS f32x4*)g1)[lane + 64 * j];
    if (gw + 3 * NGW < MPR && gw + 4 * NGW >= MPR) {
        ThinIn I0, I1, I2, I3;
        thin_load(I0, Y + (size_t)gw * DM, XB + (size_t)gw * DM, lane);
        thin_load(I1, Y + (size_t)(gw + NGW) * DM, XB + (size_t)(gw + NGW) * DM, lane);
        thin_load(I2, Y + (size_t)(gw + 2 * NGW) * DM, XB + (size_t)(gw + 2 * NGW) * DM, lane);
        thin_load(I3, Y + (size_t)(gw + 3 * NGW) * DM, XB + (size_t)(gw + 3 * NGW) * DM, lane);
        thin_fin(I0, g, XB + (size_t)gw * DM, X ? X + (size_t)gw * DM : nullptr, RS + gw, lane);
        thin_fin(I1, g, XB + (size_t)(gw + NGW) * DM, X ? X + (size_t)(gw + NGW) * DM : nullptr, RS + gw + NGW, lane);
        thin_fin(I2, g, XB + (size_t)(gw + 2 * NGW) * DM, X ? X + (size_t)(gw + 2 * NGW) * DM : nullptr, RS + gw + 2 * NGW, lane);
        thin_fin(I3, g, XB + (size_t)(gw + 3 * NGW) * DM, X ? X + (size_t)(gw + 3 * NGW) * DM : nullptr, RS + gw + 3 * NGW, lane);
        return;
    }
    ThinIn A = {}, B = {};
    int m = gw;
    if (m < MPR) thin_load(A, Y + (size_t)m * DM, XB + (size_t)m * DM, lane);
    while (m < MPR) {
        int n = m + NGW;
        if (n < MPR) thin_load(B, Y + (size_t)n * DM, XB + (size_t)n * DM, lane);
        thin_fin(A, g, XB + (size_t)m * DM, X ? X + (size_t)m * DM : nullptr, RS + m, lane);
        m = n; if (m >= MPR) break;
        n = m + NGW;
        if (n < MPR) thin_load(A, Y + (size_t)n * DM, XB + (size_t)n * DM, lane);
        thin_fin(B, g, XB + (size_t)m * DM, X ? X + (size_t)m * DM : nullptr, RS + m, lane);
        m = n;
    }
}
template <int NPARTS>
__device__ __forceinline__ void thin_row_parts(LAS unsigned char* lds, const bf16* yrow, size_t pstride, bf16* xb, float* outf, float* rs, const float* g1, int tid) {
    LAS float* red = (LAS float*)lds;
    const int wave = tid >> 6, col = 4 * tid;
    v2u pw[NPARTS];
#pragma unroll
    for (int k = 0; k < NPARTS; ++k) pw[k] = *(const GAS v2u*)(yrow + (size_t)k * pstride + col);
    const v2u xw = *(const GAS v2u*)(xb + col); const f32x4 gg1 = *(const GAS f32x4*)(g1 + col);
    const f32x4 xr = {pg8::bflo(xw.x), pg8::bfhi(xw.x), pg8::bflo(xw.y), pg8::bfhi(xw.y)};
    f32x4 y = {0.f, 0.f, 0.f, 0.f};
#pragma unroll
    for (int k = 0; k < NPARTS; ++k) y += (f32x4){pg8::bflo(pw[k].x), pg8::bfhi(pw[k].x), pg8::bflo(pw[k].y), pg8::bfhi(pw[k].y)};
    float s = wave_sum((y.x * y.x + y.y * y.y) + (y.z * y.z + y.w * y.w));
    if ((tid & 63) == 0) red[wave] = s;
    LDS_WAIT(); __syncthreads();
    float tot = 0.f;
#pragma unroll
    for (int w = 0; w < 8; ++w) tot += red[w];
    const float r1 = 1.0f / sqrtf(tot * (1.0f / DM) + EPS);
    const f32x4 x = xr + y * r1 * gg1;
    if (outf) { *(GAS f32x4*)(outf + col) = x; }
    else {
        v2u wv; wv.x = pk2(x.x, x.y); wv.y = pk2(x.z, x.w); *(GAS v2u*)(xb + col) = wv;
        float s2 = wave_sum((x.x * x.x + x.y * x.y) + (x.z * x.z + x.w * x.w));
        if ((tid & 63) == 0) red[8 + wave] = s2;
        LDS_WAIT(); __syncthreads();
        float tot2 = 0.f;
#pragma unroll
        for (int w = 0; w < 8; ++w) tot2 += red[8 + w];
        if (tid == 0) *rs = 1.0f / sqrtf(tot2 * (1.0f / DM) + EPS);
    }
    __syncthreads();
}

template <int NPARTS>
__device__ __forceinline__ void thin_row_parts2(LAS unsigned char* lds, const bf16* slabs, size_t pstride, bf16* XBs, float* outs, float* RSs, const float* g1, int j0, int j1, bool has1, int tid) {
    LAS float* red = (LAS float*)lds;
    const int wave = tid >> 6, col = 4 * tid;
    const int jj[2] = {j0, has1 ? j1 : j0};
    v2u pw[2][NPARTS], xw[2];
#pragma unroll
    for (int r = 0; r < 2; ++r) {
#pragma unroll
        for (int k = 0; k < NPARTS; ++k) pw[r][k] = *(const GAS v2u*)(slabs + (size_t)jj[r] * DM + (size_t)k * pstride + col);
        xw[r] = *(const GAS v2u*)(XBs + (size_t)jj[r] * DM + col); }
    const f32x4 gg1 = *(const GAS f32x4*)(g1 + col);
    f32x4 y[2], x[2];
#pragma unroll
    for (int r = 0; r < 2; ++r) { y[r] = (f32x4){0.f, 0.f, 0.f, 0.f};
#pragma unroll
        for (int k = 0; k < NPARTS; ++k) y[r] += (f32x4){pg8::bflo(pw[r][k].x), pg8::bfhi(pw[r][k].x), pg8::bflo(pw[r][k].y), pg8::bfhi(pw[r][k].y)};
        const float s = wave_sum((y[r].x * y[r].x + y[r].y * y[r].y) + (y[r].z * y[r].z + y[r].w * y[r].w));
        if ((tid & 63) == 0) red[16 * r + wave] = s; }
    LDS_WAIT(); __syncthreads();
#pragma unroll
    for (int r = 0; r < 2; ++r) { float tot = 0.f;
#pragma unroll
        for (int w = 0; w < 8; ++w) tot += red[16 * r + w];
        const float r1 = 1.0f / sqrtf(tot * (1.0f / DM) + EPS);
        const f32x4 xr = {pg8::bflo(xw[r].x), pg8::bfhi(xw[r].x), pg8::bflo(xw[r].y), pg8::bfhi(xw[r].y)};
        x[r] = xr + y[r] * r1 * gg1; }
    if (outs) {
        *(GAS f32x4*)(outs + (size_t)j0 * DM + col) = x[0];
        if (has1) *(GAS f32x4*)(outs + (size_t)j1 * DM + col) = x[1];
    } else {
#pragma unroll
        for (int r = 0; r < 2; ++r) { if (r == 0 || has1) { v2u wv; wv.x = pk2(x[r].x, x[r].y); wv.y = pk2(x[r].z, x[r].w); *(GAS v2u*)(XBs + (size_t)jj[r] * DM + col) = wv; }
            const float s2 = wave_sum((x[r].x * x[r].x + x[r].y * x[r].y) + (x[r].z * x[r].z + x[r].w * x[r].w));
            if ((tid & 63) == 0) red[16 * r + 8 + wave] = s2; }
        LDS_WAIT(); __syncthreads();
        if (tid < 2 && (tid == 0 || has1)) { float tot2 = 0.f;
#pragma unroll
            for (int w = 0; w < 8; ++w) tot2 += red[16 * tid + 8 + w];
            RSs[jj[tid]] = 1.0f / sqrtf(tot2 * (1.0f / DM) + EPS); }
    }
    __syncthreads();
}

__device__ __forceinline__ void conva_item(KArgs args, const bf16* PROJ, bf16* Z, int l, int item) {
    const int cg = item & 127, r0 = 4 * (item >> 7), ch0 = 8 * cg;
    const float* cw = args->in[I_CAW] + (size_t)l * 3 * DA + ch0;
    float w0[8], w1[8], w2[8];
#pragma unroll
    for (int q = 0; q < 2; ++q) { const f32x4 a = *(const GAS f32x4*)(cw + 4 * q), b = *(const GAS f32x4*)(cw + DA + 4 * q), c = *(const GAS f32x4*)(cw + 2 * DA + 4 * q);
#pragma unroll
        for (int j = 0; j < 4; ++j) { w0[4 * q + j] = a[j]; w1[4 * q + j] = b[j]; w2[4 * q + j] = c[j]; } }
    float* out = args->out;
    v4u cxw[4], gw[4];
#pragma unroll
    for (int i = 0; i < 4; ++i) { cxw[i] = *(const GAS v4u*)(PROJ + (size_t)(r0 + i) * PP + C_CX + ch0); gw[i] = *(const GAS v4u*)(PROJ + (size_t)(r0 + i) * PP + C_ABG + ch0); }
    float p2[8], p1[8];
    const bool prompt = r0 < MPR; const int t0 = r0 & (TSEQ - 1), s = (r0 - MPR) >> 2;
    if (prompt) {
        if (t0 == 0) {
#pragma unroll
            for (int j = 0; j < 8; ++j) { p2[j] = 0.f; p1[j] = 0.f; }
        } else {
            const v4u a = *(const GAS v4u*)(PROJ + (size_t)(r0 - 2) * PP + C_CX + ch0), c = *(const GAS v4u*)(PROJ + (size_t)(r0 - 1) * PP + C_CX + ch0);
#pragma unroll
            for (int q = 0; q < 4; ++q) { p2[2 * q] = pg8::bflo(a[q]); p2[2 * q + 1] = pg8::bfhi(a[q]); p1[2 * q] = pg8::bflo(c[q]); p1[2 * q + 1] = pg8::bfhi(c[q]); }
        }
    } else {
        const float* st = args->in[I_SCA] + ((size_t)(l * NS + s) * 2) * DA + ch0;
        const f32x4 a0 = *(const GAS f32x4*)st, a1 = *(const GAS f32x4*)(st + 4), b0 = *(const GAS f32x4*)(st + DA), b1 = *(const GAS f32x4*)(st + DA + 4);
#pragma unroll
        for (int j = 0; j < 4; ++j) { p2[j] = a0[j]; p2[4 + j] = a1[j]; p1[j] = b0[j]; p1[4 + j] = b1[j]; }
    }
#pragma unroll
    for (int i = 0; i < 4; ++i) { const size_t r = (size_t)(r0 + i);
        float cur[8], g[8], z[8];
#pragma unroll
        for (int q = 0; q < 4; ++q) { cur[2 * q] = pg8::bflo(cxw[i][q]); cur[2 * q + 1] = pg8::bfhi(cxw[i][q]); g[2 * q] = pg8::bflo(gw[i][q]); g[2 * q + 1] = pg8::bfhi(gw[i][q]); }
#pragma unroll
        for (int j = 0; j < 8; ++j) { z[j] = g[j] * (w0[j] * p2[j] + w1[j] * p1[j] + w2[j] * cur[j]); p2[j] = p1[j]; p1[j] = cur[j]; }
        v4u o; o.x = pk2(z[0], z[1]); o.y = pk2(z[2], z[3]); o.z = pk2(z[4], z[5]); o.w = pk2(z[6], z[7]);
        *(GAS v4u*)(Z + r * ZP + ch0) = o;
        float* o2 = nullptr;
        if (prompt) { const int t = t0 + i; if (t >= TSEQ - 2) o2 = out + O_CAP + ((size_t)(l * NB + (r0 >> 11)) * 2 + (t - (TSEQ - 2))) * DA + ch0; }
        else if (i >= 2) o2 = out + O_CAS + ((size_t)(l * NS + s) * 2 + (i - 2)) * DA + ch0;
        if (o2) { *(GAS f32x4*)o2 = (f32x4){cur[0], cur[1], cur[2], cur[3]}; *(GAS f32x4*)(o2 + 4) = (f32x4){cur[4], cur[5], cur[6], cur[7]}; }
    }
}

struct ScanRegs { v4u w[5]; f32x4 sa[3], sb[3]; };
template <int MODE>
__device__ __forceinline__ void scan_load(ScanRegs& R, KArgs args, const bf16* PROJ, int l, int bq, int c, int h, int tid) {
    const int cgp = tid & 15, rq = tid >> 4, hc0 = 128 * h;
    if (MODE == 1) {
        const int row0 = bq * TSEQ + CHL * c;
#pragma unroll
        for (int e = 0; e < 5; ++e) { const int rr = 2 * rq - 3 + e;
            R.w[e] = (v4u){0u, 0u, 0u, 0u};
            if (c > 0 || rr >= 0) R.w[e] = *(const GAS v4u*)(PROJ + (size_t)(row0 + rr) * PP + C_BX + hc0 + 8 * cgp); }
    } else {
        const int sl = rq >> 1, tok0 = 2 * (rq & 1), row0 = MPR + 64 * bq + 4 * sl;
        const float* st = args->in[I_SCB] + ((size_t)(l * NS + 16 * bq + sl) * 3) * DB + hc0 + 8 * cgp;
#pragma unroll
        for (int e = 0; e < 5; ++e) { const int ti = tok0 - 3 + e;
            R.w[e] = (v4u){0u, 0u, 0u, 0u};
            if (ti >= 0) R.w[e] = *(const GAS v4u*)(PROJ + (size_t)(row0 + ti) * PP + C_BX + hc0 + 8 * cgp); }
#pragma unroll
        for (int e = 0; e < 3; ++e) { const int ti = tok0 - 3 + e;
            R.sa[e] = (f32x4){0.f, 0.f, 0.f, 0.f}; R.sb[e] = R.sa[e];
            if (ti < 0) { R.sa[e] = *(const GAS f32x4*)(st + (size_t)(3 + ti) * DB); R.sb[e] = *(const GAS f32x4*)(st + (size_t)(3 + ti) * DB + 4); } }
    }
}
struct ScanConst { bf16x8 Br[4], Bi[4]; float br, bi, lsl; };
__device__ __forceinline__ void scan_const(ScanConst& C, KArgs args, LAS unsigned char* lds, const bf16* WRI, int l, int h, int tid) {
    const int lane = tid & 63, wid = __builtin_amdgcn_readfirstlane(tid >> 6), fr = lane & 15, fq = lane >> 4, cgp = tid & 15, hc0 = 128 * h;
    const bf16* wri = WRI + (size_t)h * 256 * 128;
#pragma unroll
    for (int kk = 0; kk < 4; ++kk) { C.Br[kk] = *(const GAS bf16x8*)(wri + (size_t)(16 * wid + fr) * 128 + 32 * kk + 8 * fq); C.Bi[kk] = *(const GAS bf16x8*)(wri + (size_t)(128 + 16 * wid + fr) * 128 + 32 * kk + 8 * fq); }
    if (tid < 160) { const int k = tid >> 5, c4 = tid & 31;
        const float* src = (k < 4) ? args->in[I_CBW] + ((size_t)l * 4 + k) * DB + hc0 + 4 * c4 : args->in[I_CBB] + (size_t)l * DB + hc0 + 4 * c4;
        *(LAS f32x4*)((LAS float*)(lds + SC_CW) + k * 128 + 4 * c4) = *(const GAS f32x4*)src; }
    (void)cgp;
    const int mg = hc0 + 16 * wid + fr;
    C.br = args->in[I_BR][(size_t)l * DB + mg]; C.bi = args->in[I_BI][(size_t)l * DB + mg];
    const float lam = args->in[I_LAM][(size_t)l * DB + mg];
    C.lsl = (fminf(lam, 0.f) - log1pf(expf(-fabsf(lam)))) * (8.0f * 1.4426950408889634f);
}
template <int MODE>
__device__ __forceinline__ void scan_unit(KArgs args, LAS unsigned char* lds, ScanRegs& R, const ScanConst& C, const bf16* PROJ, bf16* Z, bf16* HL, bf16* CA, f32x2* SUM, int l, int bq, int c, int h, int nbq, int nc, int nh, int tid) {
    const int lane = tid & 63, wid = __builtin_amdgcn_readfirstlane(tid >> 6), fr = lane & 15, fq = lane >> 4;
    LAS bf16* XH = (LAS bf16*)(lds + SC_XH);
    LAS float* XF = (LAS float*)(lds + SC_XF);
    const int row0 = (MODE == 2) ? MPR + 64 * bq : bq * TSEQ + CHL * c;
    const int hc0 = 128 * h;
    float* out = args->out;
    {
        const int cgp = tid & 15, rq = tid >> 4;
        float u[5][8];
#pragma unroll
        for (int e = 0; e < 5; ++e) {
#pragma unroll
            for (int q = 0; q < 4; ++q) { u[e][2 * q] = pg8::bflo(R.w[e][q]); u[e][2 * q + 1] = pg8::bfhi(R.w[e][q]); } }
        if (MODE == 2) { const int tok0 = 2 * (rq & 1);
#pragma unroll
            for (int e = 0; e < 3; ++e) if (tok0 - 3 + e < 0) {
#pragma unroll
                for (int j = 0; j < 4; ++j) { u[e][j] = R.sa[e][j]; u[e][4 + j] = R.sb[e][j]; } } }
        float x0[8], x1[8];
#pragma unroll
        for (int j = 0; j < 8; ++j) { const LAS float* cwl = (const LAS float*)(lds + SC_CW) + 8 * cgp + j; const float w0 = cwl[0], w1 = cwl[128], w2 = cwl[256], w3 = cwl[384], b = cwl[512];
            x0[j] = b + w0 * u[0][j] + w1 * u[1][j] + w2 * u[2][j] + w3 * u[3][j];
            x1[j] = b + w0 * u[1][j] + w1 * u[2][j] + w2 * u[3][j] + w3 * u[4][j]; }
        const int r = 2 * rq;
        *(LAS f32x4*)(XF + r * 128 + 8 * cgp) = (f32x4){x0[0], x0[1], x0[2], x0[3]}; *(LAS f32x4*)(XF + r * 128 + 8 * cgp + 4) = (f32x4){x0[4], x0[5], x0[6], x0[7]};
        *(LAS f32x4*)(XF + (r + 1) * 128 + 8 * cgp) = (f32x4){x1[0], x1[1], x1[2], x1[3]}; *(LAS f32x4*)(XF + (r + 1) * 128 + 8 * cgp + 4) = (f32x4){x1[4], x1[5], x1[6], x1[7]};
        v4u p0, p1; p0.x = pk2(x0[0], x0[1]); p0.y = pk2(x0[2], x0[3]); p0.z = pk2(x0[4], x0[5]); p0.w = pk2(x0[6], x0[7]);
        p1.x = pk2(x1[0], x1[1]); p1.y = pk2(x1[2], x1[3]); p1.z = pk2(x1[4], x1[5]); p1.w = pk2(x1[6], x1[7]);
        *(LAS v4u*)(XH + r * XHP + 8 * cgp) = p0; *(LAS v4u*)(XH + (r + 1) * XHP + 8 * cgp) = p1;
        if (MODE == 1 && c == NCH - 1 && rq == 31) {
#pragma unroll
            for (int k = 0; k < 3; ++k) { float* o = out + O_CBP + ((size_t)(l * NB + bq) * 3 + k) * DB + hc0 + 8 * cgp;
                *(GAS f32x4*)o = (f32x4){u[2 + k][0], u[2 + k][1], u[2 + k][2], u[2 + k][3]}; *(GAS f32x4*)(o + 4) = (f32x4){u[2 + k][4], u[2 + k][5], u[2 + k][6], u[2 + k][7]}; } }
        if (MODE == 2 && (rq & 1)) { const int s = 16 * bq + (rq >> 1);
#pragma unroll
            for (int k = 0; k < 3; ++k) { float* o = out + O_CBS + ((size_t)(l * NS + s) * 3 + k) * DB + hc0 + 8 * cgp;
                *(GAS f32x4*)o = (f32x4){u[2 + k][0], u[2 + k][1], u[2 + k][2], u[2 + k][3]}; *(GAS f32x4*)(o + 4) = (f32x4){u[2 + k][4], u[2 + k][5], u[2 + k][6], u[2 + k][7]}; } }
    }
    if (nbq >= 0) scan_load<MODE>(R, args, PROJ, l, nbq, nc, nh, tid);
    LDS_WAIT(); __syncthreads();
    float av[4][4], bv[4][4];
    {
        f32x4 ar[4], ai[4];
#pragma unroll
        for (int mt = 0; mt < 4; ++mt) { ar[mt] = (f32x4){0.f, 0.f, 0.f, 0.f}; ai[mt] = (f32x4){0.f, 0.f, 0.f, 0.f}; }
#pragma unroll
        for (int mt = 0; mt < 4; ++mt)
#pragma unroll
            for (int kk = 0; kk < 4; ++kk) { const bf16x8 a = *(const LAS bf16x8*)(XH + (16 * mt + fr) * XHP + 32 * kk + 8 * fq);
                ar[mt] = __builtin_amdgcn_mfma_f32_16x16x32_bf16(a, C.Br[kk], ar[mt], 0, 0, 0); ai[mt] = __builtin_amdgcn_mfma_f32_16x16x32_bf16(a, C.Bi[kk], ai[mt], 0, 0, 0); }
        const int mch = 16 * wid + fr;
#pragma unroll
        for (int mt = 0; mt < 4; ++mt)
#pragma unroll
            for (int j = 0; j < 4; ++j) { const int r = 16 * mt + 4 * fq + j;
                const float rr = pg8::fsig(ar[mt][j] + C.br), ii = pg8::fsig(ai[mt][j] + C.bi);
                const float l2 = rr * C.lsl;
                const float a = __builtin_amdgcn_exp2f(l2);
                const float y = l2 * 1.3862943611198906f;
                float em = -y * (1.0f + y * (0.5f + y * (0.16666667f + y * (0.041666668f + y * (0.008333334f + y * 0.0013888889f)))));
                em = (y > -0.35f) ? em : (1.0f - a * a);
                const float mult = __builtin_amdgcn_sqrtf(fmaxf(em, 0.f));
                av[mt][j] = a; bv[mt][j] = mult * ii * XF[r * 128 + mch]; }
    }
    LAS bf16* HT = (LAS bf16*)(lds + SC_HT);
    LAS bf16* CT = (LAS bf16*)(lds + SC_CT);
    const int mchn = 16 * wid + fr, gch = hc0 + mchn;
    if (MODE == 1) {
        float pa[4][4], pb[4][4], Ae[4], Be[4], At[4], Bt[4];
#pragma unroll
        for (int mt = 0; mt < 4; ++mt) { float A = 1.f, B = 0.f;
#pragma unroll
            for (int j = 0; j < 4; ++j) { B = av[mt][j] * B + bv[mt][j]; A *= av[mt][j]; pa[mt][j] = A; pb[mt][j] = B; }
            float Au = __shfl_up(A, 16), Bu = __shfl_up(B, 16); if (fq >= 1) { B = A * Bu + B; A = A * Au; }
            Au = __shfl_up(A, 32); Bu = __shfl_up(B, 32); if (fq >= 2) { B = A * Bu + B; A = A * Au; }
            Ae[mt] = __shfl_up(A, 16); Be[mt] = __shfl_up(B, 16); if (fq == 0) { Ae[mt] = 1.f; Be[mt] = 0.f; }
            At[mt] = __shfl(A, fr + 48); Bt[mt] = __shfl(B, fr + 48); }
        float Hc = 0.f, Ac = 1.f;
#pragma unroll
        for (int mt = 0; mt < 4; ++mt) { const float Hin = Ae[mt] * Hc + Be[mt], Ain = Ae[mt] * Ac;
#pragma unroll
            for (int j = 0; j < 4; ++j) { const int r = 16 * mt + 4 * fq + j;
                HT[r * XHP + mchn] = (bf16)f2bf(pa[mt][j] * Hin + pb[mt][j]); CT[r * XHP + mchn] = (bf16)f2bf(pa[mt][j] * Ain); }
            Hc = At[mt] * Hc + Bt[mt]; Ac = At[mt] * Ac; }
        if (fq == 0) SUM[((size_t)bq * NCH + c) * DB + gch] = (f32x2){Ac, Hc};
    } else {
#pragma unroll
        for (int mt = 0; mt < 4; ++mt) { const int s = 16 * bq + 4 * mt + fq;
            float H = args->in[I_SH][(size_t)(l * NS + s) * DB + gch];
#pragma unroll
            for (int j = 0; j < 4; ++j) { const int r = 16 * mt + 4 * fq + j; H = av[mt][j] * H + bv[mt][j]; HT[r * XHP + mchn] = (bf16)f2bf(H); }
            out[O_HS + (size_t)(l * NS + s) * DB + gch] = H; }
    }
    LDS_WAIT(); __syncthreads();
#pragma unroll
    for (int it = 0; it < 2; ++it) { const int q = tid + it * (NWAVES * 64), r = q >> 4, cc = q & 15; const size_t grow = (size_t)(row0 + r);
        const v4u hw = *(const LAS v4u*)(HT + r * XHP + 8 * cc);
        if (MODE == 1) {
            *(GAS v4u*)(HL + grow * DM + hc0 + 8 * cc) = hw;
            *(GAS v4u*)(CA + grow * DM + hc0 + 8 * cc) = *(const LAS v4u*)(CT + r * XHP + 8 * cc);
        } else {
            const v4u g = *(const GAS v4u*)(PROJ + grow * PP + C_BG + hc0 + 8 * cc);
            v4u o; o.x = pk2(pg8::bflo(hw.x) * pg8::bflo(g.x), pg8::bfhi(hw.x) * pg8::bfhi(g.x)); o.y = pk2(pg8::bflo(hw.y) * pg8::bflo(g.y), pg8::bfhi(hw.y) * pg8::bfhi(g.y));
            o.z = pk2(pg8::bflo(hw.z) * pg8::bflo(g.z), pg8::bfhi(hw.z) * pg8::bfhi(g.z)); o.w = pk2(pg8::bflo(hw.w) * pg8::bflo(g.w), pg8::bfhi(hw.w) * pg8::bfhi(g.w));
            *(GAS v4u*)(Z + grow * ZP + DA + hc0 + 8 * cc) = o;
        } }
}
__device__ __forceinline__ void fix_unit(KArgs args, LAS unsigned char* lds, const bf16* PROJ, bf16* Z, const bf16* HL, const bf16* CA, const f32x2* SUM, int l, int b, int c, int qd, int tid) {
    LAS float* HIN = (LAS float*)lds;
    const int ch0 = 512 * qd;
    const int row0 = b * TSEQ + CHL * c;
    v4u hw[8], cw[8], gw[8];
#pragma unroll
    for (int it = 0; it < 8; ++it) { const int q = tid + it * (NWAVES * 64), r = q >> 6, cc = q & 63; const size_t grow = (size_t)(row0 + r); const int col = ch0 + 8 * cc;
        hw[it] = *(const GAS v4u*)(HL + grow * DM + col); cw[it] = *(const GAS v4u*)(CA + grow * DM + col); gw[it] = *(const GAS v4u*)(PROJ + grow * PP + C_BG + col); }
    {
        float H = 0.f;
#pragma unroll
        for (int q0 = 0; q0 < 32; q0 += 8) { f32x2 sg[8];
#pragma unroll
            for (int q = 0; q < 8; ++q) { sg[q] = (f32x2){1.f, 0.f}; if (q0 + q < c) sg[q] = SUM[((size_t)b * NCH + q0 + q) * DB + ch0 + tid]; }
#pragma unroll
            for (int q = 0; q < 8; ++q) H = sg[q].x * H + sg[q].y; }
        HIN[tid] = H;
    }
    LDS_WAIT(); __syncthreads();
#pragma unroll
    for (int it = 0; it < 8; ++it) { const int q = tid + it * (NWAVES * 64), r = q >> 6, cc = q & 63; const size_t grow = (size_t)(row0 + r); const int col = ch0 + 8 * cc;
        const f32x4 i0 = *(const LAS f32x4*)(HIN + 8 * cc), i1 = *(const LAS f32x4*)(HIN + 8 * cc + 4);
        float hh[8];
        hh[0] = pg8::bflo(hw[it].x) + pg8::bflo(cw[it].x) * i0.x; hh[1] = pg8::bfhi(hw[it].x) + pg8::bfhi(cw[it].x) * i0.y; hh[2] = pg8::bflo(hw[it].y) + pg8::bflo(cw[it].y) * i0.z; hh[3] = pg8::bfhi(hw[it].y) + pg8::bfhi(cw[it].y) * i0.w;
        hh[4] = pg8::bflo(hw[it].z) + pg8::bflo(cw[it].z) * i1.x; hh[5] = pg8::bfhi(hw[it].z) + pg8::bfhi(cw[it].z) * i1.y; hh[6] = pg8::bflo(hw[it].w) + pg8::bflo(cw[it].w) * i1.z; hh[7] = pg8::bfhi(hw[it].w) + pg8::bfhi(cw[it].w) * i1.w;
        v4u o; o.x = pk2(hh[0] * pg8::bflo(gw[it].x), hh[1] * pg8::bfhi(gw[it].x)); o.y = pk2(hh[2] * pg8::bflo(gw[it].y), hh[3] * pg8::bfhi(gw[it].y));
        o.z = pk2(hh[4] * pg8::bflo(gw[it].z), hh[5] * pg8::bfhi(gw[it].z)); o.w = pk2(hh[6] * pg8::bflo(gw[it].w), hh[7] * pg8::bfhi(gw[it].w));
        *(GAS v4u*)(Z + grow * ZP + DA + col) = o;
        if (c == NCH - 1 && r == CHL - 1) { float* o2 = args->out + O_HP + (size_t)(l * NB + b) * DB + col;
            *(GAS f32x4*)o2 = (f32x4){hh[0], hh[1], hh[2], hh[3]}; *(GAS f32x4*)(o2 + 4) = (f32x4){hh[4], hh[5], hh[6], hh[7]}; }
    }
    __syncthreads();
}

__global__ void __launch_bounds__(NWAVES * 64, 2) fwd(Args args_by_value) {
    extern __shared__ __attribute__((aligned(16))) unsigned char lds_raw[];
    LAS unsigned char* lds = (LAS unsigned char*)lds_raw;
    volatile LAS unsigned* MISC = (volatile LAS unsigned*)(lds + MISC_OFF);
    const int tid = threadIdx.x, lane = tid & 63, wave = __builtin_amdgcn_readfirstlane(tid >> 6);
    const int G = gridDim.x, bx = blockIdx.x;
    const int vcu = (G % 8 == 0) ? (bx % 8) * (G / 8) + bx / 8 : bx;
    int lo, hi; unsigned* barw;
    { KArgs args = kargs(); lo = args->ph_lo; hi = args->ph_hi; barw = (unsigned*)(args->ws + WS_CTL) + CW_BAR; }
    for (int u = tid; u < (LDS_BYTES - LDSCTL_OFF) / 4; u += NWAVES * 64) ((LAS unsigned*)(lds + LDSCTL_OFF))[u] = 0u;
    __syncthreads();
    XcdBarrier bar; bar.bar = barw; bar.x = 0; bar.st = nullptr;
    if (hi - lo > 1) bar = xcd_barrier_post(barw, MISC + 8);
#ifndef PHMASK
#define PHMASK 0x7ff
#endif
#define RUN(p) (lo <= (p) && (p) < hi)
#define EN(k) ((PHMASK >> (k)) & 1)
#ifndef DUPMASK
#define DUPMASK 0
#endif
#define REP(k) for (int rep_ = 0; rep_ < 1 + ((DUPMASK >> (k)) & 1); ++rep_)
#ifndef BARX
#define BARX 0
#endif
#define SEAM(p) do { if (RUN(p) && RUN((p) + 1)) { xcd_barrier(bar); for (int bx_ = 0; bx_ < BARX; ++bx_) xcd_barrier(bar); } } while (0)
#define PH_BEGIN() KArgs args = kargs(); unsigned char* ws = args->ws; \
    bf16* XB = (bf16*)(ws + WS_U); float* RS = (float*)(ws + WS_RS); bf16* PROJ = (bf16*)(ws + WS_PROJ); bf16* Z = (bf16*)(ws + WS_Z); \
    float* TMP = (float*)(ws + WS_TMP); bf16* MRG = (bf16*)(ws + WS_MRG); float* Y32 = (float*)(ws + WS_Y32); bf16* HM = (bf16*)(ws + WS_HM); \
    f32x2* SUM = (f32x2*)(ws + WS_SUM); float* PARTS = (float*)(ws + WS_PARTS); float* X = args->out + O_X; \
    (void)XB; (void)RS; (void)PROJ; (void)Z; (void)TMP; (void)MRG; (void)Y32; (void)HM; (void)SUM; (void)PARTS; (void)X
    const int NGW = G * NWAVES;

    if (EN(0) && RUN(0)) REP(0) {
        PH_BEGIN(); const int gw = vcu * NWAVES + wave;
        LAS unsigned* T = (LAS unsigned*)(lds + RING_OFF + wave * 8448);
        convert_items(args, ws, T, 0, IT_LAYER, gw, NGW, lane);
        for (int m = gw; m < M; m += NGW) {
            const float* xin = (m < MPR) ? args->in[I_XP] + (size_t)m * DM : args->in[I_XS] + (size_t)(m - MPR) * DM;
            thin_row(nullptr, xin, XB + (size_t)m * DM, nullptr, RS + m, nullptr, lane);
        }
    }
    SEAM(0);

    for (int l = 0; l < NL; ++l) {
        const int pb = 1 + PPL * l;
#define OPAQUE_TID() int tid_o = threadIdx.x; asm volatile("" : "+v"(tid_o)); const int lane_o = tid_o & 63, wave_o = __builtin_amdgcn_readfirstlane(tid_o >> 6), gw_o = vcu * NWAVES + wave_o
        if (EN(1) && RUN(pb + 0)) REP(1) {
            PH_BEGIN(); unsigned char* wl = ws + WS_W + (size_t)l * WL_STRIDE; (void)wl;
            pg8::Gemm g{XB, (const bf16*)(wl + WL_IN), DM}; pg8::OrderFull S; S.init(M, NIN, DM, G, bx);
            pg8::EpiG1 E{PROJ, (pg8::u32x4*)Y32, RS};
            pg8::gemm_phase<pg8::EpiG1, pg8::OrderFull, true, true>(lds + RING_OFF, g, S, E);
        }
        SEAM(pb + 0);
        if (EN(2) && RUN(pb + 1)) REP(2) {
            PH_BEGIN(); unsigned char* wl = ws + WS_W + (size_t)l * WL_STRIDE;
            bf16* HL = (bf16*)TMP; bf16* CA = HL + (size_t)M * DM;
            constexpr int NPU = NB * NCH * 16, NSU = (MSA / 64) * 16;
            OPAQUE_TID(); (void)lane_o; (void)gw_o;
            if ((vcu & 1) && l + 1 < NL) { convert_items(args, ws, (LAS unsigned*)(lds + RING_OFF + wave_o * 8448), (l + 1) * IT_LAYER, (l + 2) * IT_LAYER, gw_o, NGW, lane_o); __syncthreads(); }
            {
                ScanConst C = {}; ScanRegs R = {}; int hprev = -1;
                if (vcu < NPU) { const int h = vcu & 15, bc = vcu >> 4; scan_load<1>(R, args, PROJ, l, bc / NCH, bc % NCH, h, tid_o); }
                for (int u = vcu; u < NPU; u += G) { const int h = u & 15, bc = u >> 4, c = bc % NCH, b = bc / NCH;
                    if (h != hprev) { __syncthreads(); scan_const(C, args, lds, (const bf16*)(wl + WL_RI), l, h, tid_o); LDS_WAIT(); __syncthreads(); hprev = h; }
                    const int un = u + G; const bool hn = un < NPU; const int nbc = un >> 4;
                    scan_unit<1>(args, lds, R, C, PROJ, Z, HL, CA, SUM, l, b, c, h, hn ? nbc / NCH : -1, nbc % NCH, un & 15, tid_o); }
            }
            for (int v = G - 1 - vcu; v < NSU; v += G) { const int h = v & 15, grp = v >> 4;
                int tid_s = tid_o; asm volatile("" : "+v"(tid_s));
                ScanConst C = {}; ScanRegs R = {}; __syncthreads(); scan_const(C, args, lds, (const bf16*)(wl + WL_RI), l, h, tid_s); LDS_WAIT(); __syncthreads(); scan_load<2>(R, args, PROJ, l, grp, 0, h, tid_s);
                scan_unit<2>(args, lds, R, C, PROJ, Z, HL, CA, SUM, l, grp, 0, h, -1, 0, 0, tid_s); }
            { int tid_c = tid_o; asm volatile("" : "+v"(tid_c));
              for (int it = vcu * (NWAVES * 64) + tid_c; it < (M / 4) * 128; it += G * (NWAVES * 64)) conva_item(args, PROJ, Z, l, it); }
            if (!(vcu & 1) && l + 1 < NL) { int tid_v = tid_o; asm volatile("" : "+v"(tid_v)); __syncthreads();
                convert_items(args, ws, (LAS unsigned*)(lds + RING_OFF + __builtin_amdgcn_readfirstlane(tid_v >> 6) * 8448), (l + 1) * IT_LAYER, (l + 2) * IT_LAYER, vcu * NWAVES + __builtin_amdgcn_readfirstlane(tid_v >> 6), NGW, tid_v & 63); }
        }
        SEAM(pb + 1);
        if (EN(3) && RUN(pb + 2)) REP(3) {
            PH_BEGIN();
            const bf16* HL = (const bf16*)TMP; const bf16* CA = HL + (size_t)M * DM;
            OPAQUE_TID(); (void)lane_o; (void)gw_o;
            for (int u = vcu; u < NB * NCH * 4; u += G) { const int qd = u & 3, bc = u >> 2, c = bc % NCH, b = bc / NCH;
                fix_unit(args, lds, PROJ, Z, HL, CA, SUM, l, b, c, qd, tid_o); }
        }
        SEAM(pb + 2);
        if (EN(4) && RUN(pb + 3)) REP(4) {
            PH_BEGIN(); unsigned char* wl = ws + WS_W + (size_t)l * WL_STRIDE; (void)wl;
            pg8::Gemm g{Z, (const bf16*)(wl + WL_AB), ZP}; pg8::OrderG3 S; S.init(G, bx);
            pg8::EpiG3 E{(const pg8::u32x4*)Y32, MRG, (bf16*)PARTS};
            pg8::gemm_phase<pg8::EpiG3, pg8::OrderG3, true, true>(lds + RING_OFF, g, S, E);
        }
        SEAM(pb + 3);
        if (EN(5) && RUN(pb + 4)) REP(5) {
            PH_BEGIN(); unsigned char* wl = ws + WS_W + (size_t)l * WL_STRIDE; (void)wl;
            OPAQUE_TID();
            for (int it = gw_o; it < MSA * 4; it += NGW) { const int r = it >> 2, q = it & 3;
                const bf16* p = (const bf16*)PARTS + (size_t)r * DM + 512 * q + 8 * lane_o;
                v4u pw[12];
#pragma unroll
                for (int k = 0; k < 12; ++k) pw[k] = *(const GAS v4u*)(p + (size_t)k * MSA * DM);
                float a[8] = {0.f, 0.f, 0.f, 0.f, 0.f, 0.f, 0.f, 0.f};
#pragma unroll
                for (int k = 0; k < 12; ++k) { a[0] += pg8::bflo(pw[k].x); a[1] += pg8::bfhi(pw[k].x); a[2] += pg8::bflo(pw[k].y); a[3] += pg8::bfhi(pw[k].y); a[4] += pg8::bflo(pw[k].z); a[5] += pg8::bfhi(pw[k].z); a[6] += pg8::bflo(pw[k].w); a[7] += pg8::bfhi(pw[k].w); }
                v4u o; o.x = pk2(a[0], a[1]); o.y = pk2(a[2], a[3]); o.z = pk2(a[4], a[5]); o.w = pk2(a[6], a[7]);
                *(GAS v4u*)(MRG + (size_t)(MPR + r) * DM + 512 * q + 8 * lane_o) = o; }
        }
        SEAM(pb + 4);
        if (EN(6) && RUN(pb + 5)) REP(6) {
            PH_BEGIN(); unsigned char* wl = ws + WS_W + (size_t)l * WL_STRIDE; (void)wl;
            pg8::Gemm g{MRG, (const bf16*)(wl + WL_O), DM}; pg8::OrderTail S; S.init(DM, 8, 0, G, bx);
            pg8::EpiY E{(bf16*)Y32, (bf16*)PARTS};
            pg8::gemm_phase<pg8::EpiY, pg8::OrderTail, true, true>(lds + RING_OFF, g, S, E);
        }
        SEAM(pb + 5);
        if (EN(7) && RUN(pb + 6)) {
            PH_BEGIN();
            OPAQUE_TID();
            const float* g1 = args->in[I_NQM] + (size_t)l * DM;
            thin_rows((const bf16*)Y32, XB, nullptr, RS, g1, gw_o, NGW, lane_o);
            for (int j = vcu; j < MSA; j += 2 * G)
                thin_row_parts2<8>(lds, (const bf16*)PARTS, (size_t)MSA * DM, XB + (size_t)MPR * DM, nullptr, RS + MPR, g1, j, j + G, j + G < MSA, tid_o);
        }
        SEAM(pb + 6);
        if (EN(8) && RUN(pb + 7)) REP(8) {
            PH_BEGIN(); unsigned char* wl = ws + WS_W + (size_t)l * WL_STRIDE; (void)wl;
            pg8::Gemm g{XB, (const bf16*)(wl + WL_GU), DM}; pg8::OrderFull S; S.init(M, NIN, DM, G, bx);
            pg8::EpiG5 E{HM, RS};
            pg8::gemm_phase<pg8::EpiG5, pg8::OrderFull, true, true>(lds + RING_OFF, g, S, E);
        }
        SEAM(pb + 7);
        if (EN(9) && RUN(pb + 8)) REP(9) {
            PH_BEGIN(); unsigned char* wl = ws + WS_W + (size_t)l * WL_STRIDE; (void)wl;
            pg8::Gemm g{HM, (const bf16*)(wl + WL_DN), FF}; pg8::OrderTail S; S.init(FF, 16, 12, G, bx);
            pg8::EpiY E{(bf16*)Y32, (bf16*)PARTS};
            pg8::gemm_phase<pg8::EpiY, pg8::OrderTail, true, true>(lds + RING_OFF, g, S, E);
        }
        SEAM(pb + 8);
        if (EN(10) && RUN(pb + 9)) {
            PH_BEGIN();
            OPAQUE_TID();
            const bool lastl = (l == NL - 1);
            const float* g1 = args->in[I_NQF] + (size_t)l * DM;
            thin_rows((const bf16*)Y32, XB, lastl ? X : nullptr, RS, g1, gw_o, NGW, lane_o);
            for (int j = vcu; j < MSA; j += 2 * G)
                thin_row_parts2<16>(lds, (const bf16*)PARTS, (size_t)MSA * DM, XB + (size_t)MPR * DM, lastl ? X + (size_t)MPR * DM : nullptr, RS + MPR, g1, j, j + G, j + G < MSA, tid_o);
        }
        SEAM(pb + 9);
    }
#undef RUN
#undef SEAM
}

constexpr int NPHASES = 1 + PPL * NL;
extern "C" void kernel_launch(void* const* d_in, const int* in_sizes, int n_in, void* d_out, int out_size, void* d_ws, size_t ws_size, hipStream_t stream) {
    static int grid = 0;
    if (grid == 0) {
        if (n_in != 23 || ws_size < WS_END) { fprintf(stderr, "kernel_launch: unexpected shapes: n_in %d out %d ws %zu (need %zu)\n", n_in, out_size, ws_size, (size_t)WS_END); grid = -1; return; }
        int dev = 0, cus = 0, per_cu = 0;
        if (hipGetDevice(&dev) != hipSuccess || hipDeviceGetAttribute(&cus, hipDeviceAttributeMultiprocessorCount, dev) != hipSuccess) { grid = -1; return; }
        if (hipFuncSetAttribute((const void*)fwd, hipFuncAttributeMaxDynamicSharedMemorySize, LDS_BYTES) != hipSuccess) { fprintf(stderr, "kernel_launch: hipFuncSetAttribute failed\n"); grid = -1; return; }
        if (hipOccupancyMaxActiveBlocksPerMultiprocessor(&per_cu, (const void*)fwd, NWAVES * 64, LDS_BYTES) != hipSuccess || per_cu < 1)
            fprintf(stderr, "kernel_launch: note: occupancy query reports %d workgroups per CU\n", per_cu);
        (void)hipGetLastError();
        grid = cus;
    }
    if (grid < 0) return;
    if (hipMemsetAsync((char*)d_ws + WS_CTL, 0, CTL_ZERO_BYTES, stream) != hipSuccess) { fprintf(stderr, "kernel_launch: memset failed\n"); return; }
    Args a{};
    for (int i = 0; i < 23; ++i) a.in[i] = (const float*)d_in[i];
    a.out = (float*)d_out; a.ws = (unsigned char*)d_ws;
#if MK_PER_PHASE
    for (int p = 0; p < NPHASES; ++p) { a.ph_lo = p; a.ph_hi = p + 1; hipLaunchKernelGGL(fwd, dim3(grid), dim3(NWAVES * 64), LDS_BYTES, stream, a); }
#else
    a.ph_lo = 0; a.ph_hi = NPHASES;
    hipLaunchKernelGGL(fwd, dim3(grid), dim3(NWAVES * 64), LDS_BYTES, stream, a);
#endif
    const hipError_t le = hipPeekAtLastError();
    if (le != hipSuccess) fprintf(stderr, "kernel_launch: launch failed: %s\n", hipGetErrorName(le));
}
```
